# Optimizing an MI355X kernel written in HIP

```python
import jax
import jax.numpy as jnp
from jax import lax
import numpy as np

D_MODEL = 2048
BATCH = 16
SEQ = 256
DEPTH = 2
DEC_BATCH = 2
DEC_SEQ = 4096
PAST_LEN = 512

GRID_W = 64
HG_HEADS = 8
HG_DK = 128
HG_DV = 128
HG_WIDTH = HG_HEADS * HG_DK
CV_WIDTH = D_MODEL - HG_HEADS * HG_DV
CONV_W = 3
CHUNK = 32
D_FF = 4 * D_MODEL
N_MOD = 6
IN_COLS = 5 * HG_WIDTH + 3 * CV_WIDTH
EPS = 1e-6

kernel_name = 'hybrid_hgrn2_shortconv_dit_step'


def rmsnorm(x, g):
    xf = x.astype(jnp.float32)
    y = xf * lax.rsqrt(jnp.mean(xf * xf, axis=-1, keepdims=True) + EPS)
    return (y * g.astype(jnp.float32)).astype(x.dtype)


def layer_lower_bounds(lower_bounds):
    p = jax.nn.softmax(lower_bounds.astype(jnp.float32), axis=0)
    return jnp.cumsum(p, axis=0) - p[0:1]


def hgrn2_log_forget(z, lb):
    return jax.nn.log_sigmoid(z) + jnp.log1p(lb * jnp.exp(-z))


def hgrn2_chunk_scan(q, k, v, logf, s0):
    bsz, seqlen = q.shape[0], q.shape[1]
    n_chunks = seqlen // CHUNK

    def to_chunks(a):
        return a.reshape(bsz, n_chunks, CHUNK, a.shape[2], a.shape[3]).transpose(1, 0, 3, 2, 4)

    qc, kc, vc, fc = to_chunks(q), to_chunks(k), to_chunks(v), to_chunks(logf)
    lower = jnp.tril(jnp.ones((CHUNK, CHUNK), dtype=bool))[:, :, None]

    def step(state, inp):
        qn, kn, vn, fn = inp
        b = jnp.cumsum(fn, axis=2)
        diff = b[:, :, :, None, :] - b[:, :, None, :, :]
        decay = jnp.where(lower, jnp.exp(jnp.where(lower, diff, 0.0)), 0.0)
        scores = jnp.einsum('bhtsd,bhsd->bhts', decay * qn[:, :, :, None, :], kn)
        out = (jnp.einsum('bhts,bhsv->bhtv', scores, vn)
               + jnp.einsum('bhtd,bhdv->bhtv', qn * jnp.exp(b), state))
        b_last = b[:, :, -1:, :]
        state = (jnp.exp(b_last[:, :, 0, :])[..., None] * state
                 + jnp.einsum('bhsd,bhsv->bhdv', kn * jnp.exp(b_last - b), vn))
        return state, out

    s_final, out = lax.scan(step, s0, (qc, kc, vc, fc))
    out = out.transpose(1, 0, 3, 2, 4).reshape(bsz, seqlen, HG_HEADS, HG_DV)
    return out, s_final


def hgrn2_bidirectional(q, v, z_f, z_b, lb, s0_f, s0_b):
    lb_f = lb[0].reshape(HG_HEADS, HG_DK)
    lb_b = lb[1].reshape(HG_HEADS, HG_DK)
    logf_f = hgrn2_log_forget(z_f, lb_f)
    o_f, s_f = hgrn2_chunk_scan(q, -jnp.expm1(logf_f), v, logf_f, s0_f)
    flip = lambda a: jnp.flip(a, axis=1)
    logf_b = flip(hgrn2_log_forget(z_b, lb_b))
    o_b, s_b = hgrn2_chunk_scan(flip(q), -jnp.expm1(logf_b), flip(v), logf_b, s0_b)
    return o_f + flip(o_b), s_f, s_b


def centred_conv3(u, w, axis):
    n = u.shape[axis]
    pad_cfg = [(0, 0)] * u.ndim
    pad_cfg[axis] = (1, 1)
    p = jnp.pad(u, pad_cfg)
    sl = lambda s: lax.slice_in_dim(p, s, s + n, axis=axis)
    return w[0] * sl(0) + w[1] * sl(1) + w[2] * sl(2)


def trunk_layer(x, mod, s0_f, s0_b, grid, norm1_g, norm2_g, w_in, lb, hg_norm_g,
                conv_w, w_out, w_mlp1, w_mlp2):
    bsz, seqlen, _ = x.shape
    shift1, scale1, gate1, shift2, scale2, gate2 = jnp.split(mod, N_MOD, axis=-1)
    h = rmsnorm(x, norm1_g) * (1 + scale1) + shift1
    proj = h @ w_in
    cuts = [HG_WIDTH, 2 * HG_WIDTH, 3 * HG_WIDTH, 4 * HG_WIDTH, 5 * HG_WIDTH,
            5 * HG_WIDTH + CV_WIDTH, 5 * HG_WIDTH + 2 * CV_WIDTH]
    q, iv, z_f, z_b, g_out, cv_b, cv_c, cv_u = jnp.split(proj, cuts, axis=-1)

    heads = lambda a: a.reshape(bsz, seqlen, HG_HEADS, -1).astype(jnp.float32)
    o, s_f, s_b = hgrn2_bidirectional(jax.nn.silu(heads(q)), heads(iv), heads(z_f), heads(z_b),
                                      lb, s0_f, s0_b)
    o = rmsnorm(o, hg_norm_g.reshape(HG_HEADS, HG_DV)).reshape(bsz, seqlen, HG_HEADS * HG_DV)
    o = o.astype(x.dtype) * jax.nn.silu(g_out)

    u = cv_c * cv_u
    if grid is None:
        conv = centred_conv3(u, conv_w, 1)
    else:
        rows, axis = grid
        conv = centred_conv3(u.reshape(bsz, rows, GRID_W, CV_WIDTH), conv_w, axis)
        conv = conv.reshape(bsz, seqlen, CV_WIDTH)
    y_conv = cv_b * conv

    mix = jnp.concatenate([o, y_conv], axis=-1) @ w_out
    x = x + gate1 * mix
    h2 = rmsnorm(x, norm2_g) * (1 + scale2) + shift2
    x = x + gate2 * (jnp.square(jax.nn.relu(h2 @ w_mlp1)) @ w_mlp2)
    return x, s_f, s_b


def setup_inputs(seed: int = 0) -> dict:
    key = jax.random.key(seed)
    ks = jax.random.split(key, 18)
    nrm = lambda k, shape, s: jax.random.normal(k, shape, jnp.float32) * s
    d_sc = D_MODEL ** -0.5
    return {
        'x_prompt': nrm(ks[0], (BATCH, SEQ, D_MODEL), 1.0),
        'x_sample': nrm(ks[1], (DEC_BATCH, DEC_SEQ, D_MODEL), 1.0),
        'state_hgrn': nrm(ks[2], (DEC_BATCH, DEPTH, 2, HG_HEADS, HG_DK, HG_DV), 0.5),
        'c': nrm(ks[3], (DEC_BATCH, D_MODEL), 1.0),
        'c_ctx': nrm(ks[4], (D_MODEL,), 1.0),
        'norm1_g': 1.0 + nrm(ks[5], (DEPTH, D_MODEL), 0.05),
        'norm2_g': 1.0 + nrm(ks[6], (DEPTH, D_MODEL), 0.05),
        'w_ada': nrm(ks[7], (DEPTH, D_MODEL, N_MOD * D_MODEL), 0.5 * d_sc),
        'b_ada': nrm(ks[8], (DEPTH, N_MOD * D_MODEL), 0.02),
        'w_in': nrm(ks[9], (DEPTH, D_MODEL, IN_COLS), d_sc),
        'lower_bounds': nrm(ks[10], (DEPTH, 2, HG_WIDTH), 0.5),
        'hg_norm_g': 1.0 + nrm(ks[11], (DEPTH, HG_HEADS * HG_DV), 0.05),
        'conv_w': nrm(ks[12], (DEPTH, CONV_W, CV_WIDTH), CONV_W ** -0.5),
        'w_out': nrm(ks[13], (DEPTH, D_MODEL, D_MODEL), d_sc),
        'w_mlp1': nrm(ks[14], (DEPTH, D_MODEL, D_FF), d_sc),
        'w_mlp2': nrm(ks[15], (DEPTH, D_FF, D_MODEL), D_FF ** -0.5),
        'final_g': 1.0 + nrm(ks[16], (D_MODEL,), 0.05),
    }


def reference(x_prompt, x_sample, state_hgrn, c, c_ctx, norm1_g, norm2_g, w_ada, b_ada, w_in,
              lower_bounds, hg_norm_g, conv_w, w_out, w_mlp1, w_mlp2, final_g):
    lbs = layer_lower_bounds(lower_bounds)
    rows = x_sample.shape[1] // GRID_W
    zero_state = jnp.zeros((x_prompt.shape[0], HG_HEADS, HG_DK, HG_DV), jnp.float32)
    xp, xs = x_prompt, x_sample
    new_states = []
    for l in range(DEPTH):
        weights = (norm1_g[l], norm2_g[l], w_in[l], lbs[l], hg_norm_g[l], conv_w[l],
                   w_out[l], w_mlp1[l], w_mlp2[l])
        mod_ctx = (jax.nn.silu(c_ctx) @ w_ada[l] + b_ada[l])[None, None, :]
        mod_lat = (jax.nn.silu(c) @ w_ada[l] + b_ada[l])[:, None, :]
        xp, s_f, s_b = trunk_layer(xp, mod_ctx, zero_state, zero_state, None, *weights)
        new_states.append(jnp.stack([s_f, s_b], axis=1))
        cache_l = state_hgrn[:, l].astype(jnp.float32)
        conv_axis = 2 if l % 2 == 0 else 1
        xs, _, _ = trunk_layer(xs, mod_lat, cache_l[:, 0], cache_l[:, 1], (rows, conv_axis), *weights)
    new_state_hgrn = jnp.stack(new_states, axis=1).astype(x_prompt.dtype)
    y_prompt = rmsnorm(xp, final_g)
    y_sample = rmsnorm(xs, final_g)
    return (y_prompt, y_sample, new_state_hgrn)
```

```cpp
#include <hip/hip_runtime.h>
#include <hip/hip_cooperative_groups.h>
#include <cstdio>
namespace cg = cooperative_groups;

#ifndef REP_GBIG
#define REP_GBIG 1
#endif
#ifndef REP_HG
#define REP_HG 1
#endif
#ifndef REP_MISC
#define REP_MISC 1
#endif
#ifndef REP_PRO
#define REP_PRO 1
#endif
#ifndef REP_CB
#define REP_CB 1
#endif
#ifndef REP_H1
#define REP_H1 1
#endif
#ifndef MK_SINGLE
#define MK_SINGLE 1
#endif

#define LAS __attribute__((address_space(3)))
typedef unsigned short bf16_t;
typedef short bf16x8 __attribute__((ext_vector_type(8)));
typedef short bf16x4 __attribute__((ext_vector_type(4)));
typedef float f32x4 __attribute__((ext_vector_type(4)));
typedef unsigned u32x4 __attribute__((ext_vector_type(4)));
typedef unsigned u32x2 __attribute__((ext_vector_type(2)));

constexpr int DM = 2048, NCTX = 4096, NTOK = 12288, HW = 1024, INC = 8192, DFF = 8192, MODW = 12288;
constexpr int NSEG = 8;
constexpr int SEGCH = 128 / NSEG;
constexpr float EPS = 1e-6f;
constexpr int KS_ADA = 16;
constexpr int NPHASE = 21;
constexpr int LDS_BYTES = 135168;

constexpr size_t MiB = 1u << 20;
constexpr size_t WS_WIN = 0;
constexpr size_t WS_WOUT = 64 * MiB;
constexpr size_t WS_WM1 = 80 * MiB;
constexpr size_t WS_WM2 = 144 * MiB;
constexpr size_t WS_XRES = 208 * MiB;
constexpr size_t WS_HB = 304 * MiB;
constexpr size_t WS_PROJ = 352 * MiB;
constexpr size_t WS_OF = 544 * MiB;
constexpr size_t WS_MODP = 640 * MiB;
constexpr size_t WS_MOD = 645 * MiB;
constexpr size_t WS_SEGL = 646 * MiB;
constexpr size_t WS_SEGD = 662 * MiB;
constexpr size_t WS_BAR = 663 * MiB;
constexpr size_t WS_PART = 664 * MiB;
constexpr size_t WS_END = 696 * MiB;

__device__ __forceinline__ float bf2f(unsigned short b) { return __uint_as_float((unsigned)b << 16); }
__device__ __forceinline__ unsigned cvt_pk_bf16(float lo, float hi) { unsigned r; asm volatile("v_cvt_pk_bf16_f32 %0, %1, %2" : "=v"(r) : "v"(lo), "v"(hi)); return r; }
__device__ __forceinline__ unsigned short f2bf(float f) { return (unsigned short)(cvt_pk_bf16(f, 0.f) & 0xffffu); }
__device__ __forceinline__ void unpack8(const u32x4 r, float (&f)[8]) {
    f[0] = __uint_as_float(r.x << 16); f[1] = __uint_as_float(r.x & 0xffff0000u);
    f[2] = __uint_as_float(r.y << 16); f[3] = __uint_as_float(r.y & 0xffff0000u);
    f[4] = __uint_as_float(r.z << 16); f[5] = __uint_as_float(r.z & 0xffff0000u);
    f[6] = __uint_as_float(r.w << 16); f[7] = __uint_as_float(r.w & 0xffff0000u);
}
__device__ __forceinline__ f32x4 ld4_bf16(const bf16_t* p) { const u32x2 w = *(const u32x2*)p; return (f32x4){__uint_as_float(w.x << 16), __uint_as_float(w.x & 0xffff0000u), __uint_as_float(w.y << 16), __uint_as_float(w.y & 0xffff0000u)}; }
__device__ __forceinline__ float wave_sum(float v) {
#pragma unroll
    for (int o = 1; o < 64; o <<= 1) v += __shfl_xor(v, o);
    return v;
}
__device__ __forceinline__ float sigmoidf_fast(float x) { return __builtin_amdgcn_rcpf(1.0f + __expf(-x)); }
#define LDS_WAIT() asm volatile("s_waitcnt lgkmcnt(0)" ::: "memory")
#define LBAR() do { asm volatile("s_waitcnt lgkmcnt(0)" ::: "memory"); __builtin_amdgcn_s_barrier(); asm volatile("" ::: "memory"); } while (0)

namespace pg8 {
constexpr int BM = 256, BK = 64, HALF = 128, HTB = HALF * BK * 2, STAGE_BYTES = 8 * HTB, NXCD = 8, WGM = 8;
__device__ __forceinline__ int lds_byte(int r, int c) { const int st = (r >> 4) * 2 + (c >> 5), rr = r & 15, cc = c & 31, ob = rr * 64 + cc * 2; return st * 1024 + (ob ^ (((ob >> 9) & 1) << 5)); }
__device__ __forceinline__ void stage_rc(int b, int& R, int& C) { const int st = b / 1024, sb = b % 1024, swz = sb ^ (((sb >> 9) & 1) << 5); R = (st >> 1) * 16 + swz / 64; C = (st & 1) * 32 + (swz % 64) / 2; }
__device__ __forceinline__ int perm32(int rho) { const int n = rho >> 4, i = rho & 15; return 8 * (i >> 2) + 4 * n + (i & 3); }
struct Unit { int pm, pn, kt0, nkt, mode, slot; };
struct Gemm { const bf16_t* A; const bf16_t* Bt; int M, N, K; float* part; unsigned* flags; };
__device__ __forceinline__ void tile_of(int L, int nM, int nN, int nwg, int& pm, int& pn) {
    int wgid = L; { const int q = nwg / NXCD, r = nwg % NXCD, xcd = wgid % NXCD, off = wgid / NXCD; wgid = (xcd < r ? xcd * (q + 1) : r * (q + 1) + (xcd - r) * q) + off; }
    const int nig = WGM * nN, gid = wgid / nig, fm = gid * WGM, gsz = (nM - fm) < WGM ? (nM - fm) : WGM;
    pm = fm + ((wgid % nig) % gsz); pn = (wgid % nig) / gsz;
}
struct StaticOrder {
    int nM, nN, nwg, G, c, nt;
    __device__ void init(int M, int N, int K, int G_, int c_) { nM = M / BM; nN = N / BM; nwg = nM * nN; G = G_; c = c_; nt = K / BK; }
    __device__ bool next(int i, Unit& u) const {
        const long L = (long)i * G + c; if (L >= nwg) return false;
        tile_of((int)L, nM, nN, nwg, u.pm, u.pn); u.kt0 = 0; u.nkt = nt; u.mode = 0; u.slot = 0; return true;
    }
};
struct SplitOrder {
    int nM, nN, nwg, G, c, nt; bool split;
    __device__ void init(int M, int N, int K, int G_, int c_) { nM = M / BM; nN = N / BM; nwg = nM * nN; G = G_; c = c_; nt = K / BK; split = (2 * nwg == 3 * G) && (nt % 4 == 0) && (G % 16 == 0) && (nwg % 8 == 0); }
    __device__ bool next(int i, Unit& u) const {
        const int x = c & 7, j = c >> 3, q = j >> 1, r = j & 1;
        const bool half = (r == 0) ? (i == 0) : (i == 1);
        const int tau = 3 * q + (half ? 1 : (r == 0 ? 0 : 2));
        const int wg_split = x * (nwg >> 3) + tau;
        const int Ls = i * G + c; int ws = Ls < nwg ? Ls : 0; { const int qq = nwg / NXCD, rr = nwg % NXCD, xcd = ws % NXCD, off = ws / NXCD; ws = (xcd < rr ? xcd * (qq + 1) : rr * (qq + 1) + (xcd - rr) * qq) + off; }
        const int wgid = split ? wg_split : ws;
        const bool ok = split ? (i < 2) : (Ls < nwg);
        u.kt0 = (split && half && r == 1) ? (nt >> 1) : 0; u.nkt = (split && half) ? (nt >> 1) : nt; u.mode = (split && half) ? (r == 0 ? 1 : 2) : 0; u.slot = x * (G >> 4) + q;
        const int nig = WGM * nN, gid = wgid / nig, fm = gid * WGM, gsz = (nM - fm) < WGM ? (nM - fm) : WGM;
        u.pm = fm + ((wgid % nig) % gsz); u.pn = (wgid % nig) / gsz; return ok;
    }
};

template <int ACT  > struct EpiBf16 {
    static constexpr bool PERM = true;
    bf16_t* O; int ldc;
    __device__ __forceinline__ void operator()(const f32x4 (&acc)[2][2][4][2], const Unit& u, int wr, int wc, int fr, int fq) const {
        const int row0 = u.pm * BM + wr * 64 + fr; const int col0 = u.pn * BM + wc * 32 + 8 * fq;
        if (ACT == 0 && u.pn >= 24) {
            const int colq = 6144 + (u.pn - 24) * HALF + wc * 32 + 8 * fq;
#pragma unroll
            for (int ai = 0; ai < 2; ++ai)
#pragma unroll
                for (int m = 0; m < 4; ++m) { const f32x4 v0 = acc[ai][0][m][0] * acc[ai][1][m][0], v1 = acc[ai][0][m][1] * acc[ai][1][m][1];
                    u32x4 w; w.x = cvt_pk_bf16(v0[0], v0[1]); w.y = cvt_pk_bf16(v0[2], v0[3]); w.z = cvt_pk_bf16(v1[0], v1[1]); w.w = cvt_pk_bf16(v1[2], v1[3]);
                    *(u32x4*)(O + (size_t)(row0 + ai * HALF + m * 16) * ldc + colq) = w; }
            return;
        }
#pragma unroll
        for (int ai = 0; ai < 2; ++ai)
#pragma unroll
            for (int m = 0; m < 4; ++m) { bf16_t* rowp = O + (size_t)(row0 + ai * HALF + m * 16) * ldc + col0;
#pragma unroll
                for (int bj = 0; bj < 2; ++bj) { f32x4 v0 = acc[ai][bj][m][0], v1 = acc[ai][bj][m][1];
                    if (ACT == 0) { if (u.pn < 4) {
#pragma unroll
                        for (int j = 0; j < 4; ++j) { v0[j] = v0[j] * __builtin_amdgcn_rcpf(1.0f + __builtin_amdgcn_exp2f(v0[j] * -1.44269504f)); v1[j] = v1[j] * __builtin_amdgcn_rcpf(1.0f + __builtin_amdgcn_exp2f(v1[j] * -1.44269504f)); } } }
                    if (ACT == 1) {
#pragma unroll
                        for (int j = 0; j < 4; ++j) { const float a = fmaxf(v0[j], 0.f), b = fmaxf(v1[j], 0.f); v0[j] = a * a; v1[j] = b * b; } }
                    u32x4 w; w.x = cvt_pk_bf16(v0[0], v0[1]); w.y = cvt_pk_bf16(v0[2], v0[3]); w.z = cvt_pk_bf16(v1[0], v1[1]); w.w = cvt_pk_bf16(v1[2], v1[3]);
                    *(u32x4*)(rowp + bj * HALF) = w; } }
    }
};
struct EpiRes {
    static constexpr bool PERM = true;
    const float* xp; const float* xs; const bf16_t* xin; bf16_t* xout; const float* mod; int gate_off; int layer0;
    __device__ __forceinline__ void operator()(const f32x4 (&acc)[2][2][4][2], const Unit& u, int wr, int wc, int fr, int fq) const {
        const int grp = u.pm < 16 ? 0 : (u.pm < 32 ? 1 : 2);
        const float* gate = mod + grp * MODW + gate_off;
        const float* base = u.pm < 16 ? xp + (size_t)u.pm * BM * DM : xs + (size_t)(u.pm - 16) * BM * DM;
        const bf16_t* baseb = xin + (size_t)u.pm * BM * DM;
        bf16_t* out = xout + (size_t)u.pm * BM * DM;
        const int row0 = wr * 64 + fr, col0 = u.pn * BM + wc * 32 + 8 * fq;
        f32x4 gv[2][2];
#pragma unroll
        for (int bj = 0; bj < 2; ++bj)
#pragma unroll
            for (int n = 0; n < 2; ++n) gv[bj][n] = *(const f32x4*)(gate + col0 + bj * HALF + 4 * n);
#pragma unroll
        for (int ai = 0; ai < 2; ++ai)
#pragma unroll
            for (int m = 0; m < 4; ++m) { const size_t off = (size_t)(row0 + ai * HALF + m * 16) * DM + col0;
#pragma unroll
                for (int bj = 0; bj < 2; ++bj) {
                    f32x4 b0, b1;
                    if (layer0) { b0 = *(const f32x4*)(base + off + bj * HALF); b1 = *(const f32x4*)(base + off + bj * HALF + 4); }
                    else { float t8[8]; unpack8(*(const u32x4*)(baseb + off + bj * HALF), t8); b0 = (f32x4){t8[0], t8[1], t8[2], t8[3]}; b1 = (f32x4){t8[4], t8[5], t8[6], t8[7]}; }
                    const f32x4 y0 = b0 + gv[bj][0] * acc[ai][bj][m][0], y1 = b1 + gv[bj][1] * acc[ai][bj][m][1];
                    *(u32x4*)(out + off + bj * HALF) = (u32x4){cvt_pk_bf16(y0.x, y0.y), cvt_pk_bf16(y0.z, y0.w), cvt_pk_bf16(y1.x, y1.y), cvt_pk_bf16(y1.z, y1.w)}; }
                asm volatile("" ::: "memory"); }
    }
};

template <class Epi, class Sched, bool SPLIT>
__device__ __forceinline__ void gemm_phase(LAS unsigned char* lds, const Gemm g, const Sched& S, const Epi& E, const int tid) {
    const int wid = __builtin_amdgcn_readfirstlane(tid >> 6), lane = tid & 63, wr = wid >> 2, wc = wid & 3, fr = lane & 15, fq = lane >> 4;
    const int K = g.K;
    unsigned voffA[2], voffB[2];
#pragma unroll
    for (int i = 0; i < 2; ++i) { int R, C; stage_rc(tid * 16 + i * 8192, R, C); const int Rb = Epi::PERM ? ((R & ~31) + perm32(R & 31)) : R;
        voffA[i] = (unsigned)(R * K + C) * 2u; voffB[i] = (unsigned)(Rb * K + C) * 2u; }
    const size_t kstep = (size_t)(BK * 2);
    const size_t hstep = (size_t)HALF * K * 2;
    const size_t tstep = 2 * hstep;
    const unsigned ldsw = (unsigned)wid * 1024u;
    const int aoff = lds_byte(wr * 64 + fr, fq * 8), boff = lds_byte(wc * 32 + fr, fq * 8);
#define PG8_SA(b, h) (((b) * 2 + (h)) * HTB)
#define PG8_SB(b, h) ((4 + (b) * 2 + (h)) * HTB)
#define PG8_STAGE(bufoff, gbase, voff) do { _Pragma("unroll") for (int _i = 0; _i < 2; ++_i) \
        __builtin_amdgcn_global_load_lds((const unsigned*)((const char*)(gbase) + (voff)[_i]), (LAS unsigned*)(lds + (bufoff) + ldsw + _i * 8192), 16, 0, 0); } while (0)
#define PG8_LDA(dst, b, h) do { _Pragma("unroll") for (int m = 0; m < 4; ++m) _Pragma("unroll") for (int k = 0; k < 2; ++k) dst[m][k] = *(const LAS bf16x8*)(lds + PG8_SA(b, h) + aoff + m * 2048 + k * 1024); } while (0)
#define PG8_LDB(dst, b, h) do { _Pragma("unroll") for (int n = 0; n < 2; ++n) _Pragma("unroll") for (int k = 0; k < 2; ++k) dst[n][k] = *(const LAS bf16x8*)(lds + PG8_SB(b, h) + boff + n * 2048 + k * 1024); } while (0)
#define PG8_MMA(ai, bj, At, Bt) do { __builtin_amdgcn_s_setprio(1); _Pragma("unroll") for (int m = 0; m < 4; ++m) _Pragma("unroll") for (int n = 0; n < 2; ++n) _Pragma("unroll") for (int k = 0; k < 2; ++k) \
        acc[ai][bj][m][n] = __builtin_amdgcn_mfma_f32_16x16x32_bf16(Bt[n][k], At[m][k], acc[ai][bj][m][n], 0, 0, 0); __builtin_amdgcn_s_setprio(0); } while (0)
#define PG8_WAIT_V(n) asm volatile("s_waitcnt vmcnt(" #n ")" ::: "memory")
#define PG8_WAIT_L(n) asm volatile("s_waitcnt lgkmcnt(" #n ")" ::: "memory")
#define PG8_BAR __builtin_amdgcn_s_barrier()
#define PG8_SCHED __builtin_amdgcn_sched_barrier(0)
    Unit cur, nxt; int ui = 0;
    if (!S.next(0, cur)) return;
    f32x4 acc[2][2][4][2];
#pragma unroll
    for (int a = 0; a < 2; ++a)
#pragma unroll
        for (int b = 0; b < 2; ++b)
#pragma unroll
            for (int m = 0; m < 4; ++m)
#pragma unroll
                for (int n = 0; n < 2; ++n) acc[a][b][m][n] = (f32x4){0.f, 0.f, 0.f, 0.f};
    bf16x8 At[4][2], B0[2][2], B1[2][2];
    const char* cA = (const char*)g.A + (size_t)cur.pm * tstep + (size_t)cur.kt0 * kstep; const char* cB = (const char*)g.Bt + (size_t)cur.pn * tstep + (size_t)cur.kt0 * kstep;
    PG8_STAGE(PG8_SB(0, 0), cB, voffB); PG8_STAGE(PG8_SA(0, 0), cA, voffA); PG8_STAGE(PG8_SB(0, 1), cB + hstep, voffB); PG8_STAGE(PG8_SA(0, 1), cA + hstep, voffA);
    if (wr == 1) PG8_BAR;
    PG8_WAIT_V(4); PG8_BAR;
    PG8_STAGE(PG8_SB(1, 0), cB + kstep, voffB); PG8_STAGE(PG8_SA(1, 0), cA + kstep, voffA); PG8_STAGE(PG8_SB(1, 1), cB + hstep + kstep, voffB);
    PG8_WAIT_V(6); PG8_BAR;
    for (;;) {
        const bool has_next = S.next(ui + 1, nxt);
        const char* nA = has_next ? (const char*)g.A + (size_t)nxt.pm * tstep + (size_t)nxt.kt0 * kstep : cA; const char* nB = has_next ? (const char*)g.Bt + (size_t)nxt.pn * tstep + (size_t)nxt.kt0 * kstep : cB;
        const int nt = cur.nkt;
        for (int t = 0; t < nt; t += 2) {
            const bool last = (t == nt - 2);
            const char* a1 = cA + (size_t)(t + 1) * kstep;
            const char* a2 = last ? nA : cA + (size_t)(t + 2) * kstep; const char* b2 = last ? nB : cB + (size_t)(t + 2) * kstep;
            const char* a3 = a2 + kstep; const char* b3 = b2 + kstep;
            PG8_LDB(B0, 0, 0); PG8_SCHED; PG8_LDA(At, 0, 0); PG8_STAGE(PG8_SA(1, 1), a1 + hstep, voffA);
            PG8_WAIT_L(8); PG8_BAR; PG8_WAIT_L(0); PG8_MMA(0, 0, At, B0); PG8_BAR; PG8_SCHED;
            PG8_LDB(B1, 0, 1); PG8_STAGE(PG8_SB(0, 0), b2, voffB);
            PG8_BAR; PG8_WAIT_L(0); PG8_MMA(0, 1, At, B1); PG8_BAR;
            PG8_LDA(At, 0, 1); PG8_STAGE(PG8_SA(0, 0), a2, voffA);
            PG8_BAR; PG8_WAIT_L(0); PG8_MMA(1, 0, At, B0); PG8_BAR; PG8_SCHED;
            PG8_STAGE(PG8_SB(0, 1), b2 + hstep, voffB);
            PG8_WAIT_V(6); PG8_BAR; PG8_MMA(1, 1, At, B1); PG8_BAR;
            PG8_LDB(B0, 1, 0); PG8_SCHED; PG8_LDA(At, 1, 0); PG8_STAGE(PG8_SA(0, 1), a2 + hstep, voffA);
            PG8_WAIT_L(8); PG8_BAR; PG8_WAIT_L(0); PG8_MMA(0, 0, At, B0); PG8_BAR; PG8_SCHED;
            PG8_LDB(B1, 1, 1); PG8_STAGE(PG8_SB(1, 0), b3, voffB);
            PG8_BAR; PG8_WAIT_L(0); PG8_MMA(0, 1, At, B1); PG8_BAR;
            PG8_LDA(At, 1, 1); PG8_STAGE(PG8_SA(1, 0), a3, voffA);
            PG8_BAR; PG8_WAIT_L(0); PG8_MMA(1, 0, At, B0); PG8_BAR; PG8_SCHED;
            PG8_STAGE(PG8_SB(1, 1), b3 + hstep, voffB);
            PG8_WAIT_V(6); PG8_BAR; PG8_MMA(1, 1, At, B1); PG8_BAR;
        }
        if (SPLIT && cur.mode != 0) {
            const bool wr_part = (cur.mode == 1);
            if (!wr_part) {
                unsigned sp_ = 0;
                while ((unsigned)__builtin_amdgcn_readfirstlane(__hip_atomic_load(g.flags + cur.slot * 16, __ATOMIC_RELAXED, __HIP_MEMORY_SCOPE_AGENT)) < 8u) { __builtin_amdgcn_s_sleep(2); if (++sp_ > (1u << 24)) break; }
                __builtin_amdgcn_fence(__ATOMIC_ACQUIRE, "agent");
                asm volatile("s_waitcnt vmcnt(0)" ::: "memory");
            }
            float* sp = g.part + (size_t)cur.slot * 65536 + tid * 4;
#pragma unroll
            for (int a = 0; a < 2; ++a)
#pragma unroll
                for (int b = 0; b < 2; ++b)
#pragma unroll
                    for (int m = 0; m < 4; ++m) {
#pragma unroll
                        for (int n = 0; n < 2; ++n) {
                            if (wr_part) *(f32x4*)sp = acc[a][b][m][n]; else acc[a][b][m][n] += *(const f32x4*)sp;
                            sp += 2048; asm volatile("" : "+v"(sp)); }
                        asm volatile("" ::: "memory"); }
            if (wr_part) {
                asm volatile("s_waitcnt vmcnt(0)" ::: "memory");
                __builtin_amdgcn_fence(__ATOMIC_RELEASE, "agent");
                asm volatile("s_waitcnt vmcnt(0)" ::: "memory");
                if (lane == 0) __hip_atomic_fetch_add(g.flags + cur.slot * 16, 1u, __ATOMIC_RELAXED, __HIP_MEMORY_SCOPE_AGENT);
            }
        }
        if (!(SPLIT && cur.mode == 1)) E(acc, cur, wr, wc, fr, fq);
        if (!has_next) break;
#pragma unroll
        for (int a = 0; a < 2; ++a)
#pragma unroll
            for (int b = 0; b < 2; ++b)
#pragma unroll
                for (int m = 0; m < 4; ++m)
#pragma unroll
                    for (int n = 0; n < 2; ++n) acc[a][b][m][n] = (f32x4){0.f, 0.f, 0.f, 0.f};
        cur = nxt; cA = nA; cB = nB; ++ui;
    }
    PG8_WAIT_V(0);
    if (wr == 0) PG8_BAR;
    PG8_BAR;
#undef PG8_SA
#undef PG8_SB
#undef PG8_STAGE
#undef PG8_LDA
#undef PG8_LDB
#undef PG8_MMA
#undef PG8_WAIT_V
#undef PG8_WAIT_L
#undef PG8_BAR
#undef PG8_SCHED
}
}

struct Args { const float* in[17]; float* out; unsigned char* ws; int ph_lo, ph_hi; };
typedef const __attribute__((address_space(4))) Args CArgs;
enum { I_XP = 0, I_XS, I_STATE, I_C, I_CCTX, I_N1G, I_N2G, I_WADA, I_BADA, I_WIN, I_LB, I_HGG, I_CONVW, I_WOUT, I_WM1, I_WM2, I_FING };

template <bool CUPAIR> __device__ __forceinline__ void p0_transpose_item(const float* __restrict__ W, int K, int N, bf16_t* __restrict__ WT, LAS float* scr, int item, int lane) {
    const int nblk = N / 32, kb = item / nblk, nb = item % nblk, k0 = 64 * kb, n0 = 32 * nb;
    int n0d = n0;
    if (CUPAIR && n0 >= 6144) { const int isu = n0 >= 7168 ? 1 : 0, ch0 = n0 - (isu ? 7168 : 6144); n0d = 6144 + 256 * (ch0 >> 7) + 128 * isu + (ch0 & 127); }
    float tmp[32];
#pragma unroll
    for (int i = 0; i < 32; ++i) { const int kk = 2 * i + (lane >> 5); tmp[i] = __builtin_nontemporal_load(&W[(size_t)(k0 + kk) * N + n0 + (lane & 31)]);   }
#pragma unroll
    for (int i = 0; i < 32; ++i) { const int kk = 2 * i + (lane >> 5); scr[kk * 33 + (lane & 31)] = tmp[i]; }
    LDS_WAIT(); asm volatile("" ::: "memory");
    const int c = lane & 7;
#pragma unroll
    for (int j = 0; j < 4; ++j) { const int n = (lane >> 3) + 8 * j; const LAS float* s = scr + (8 * c) * 33 + n;
        u32x4 o; o.x = cvt_pk_bf16(s[0 * 33], s[1 * 33]); o.y = cvt_pk_bf16(s[2 * 33], s[3 * 33]); o.z = cvt_pk_bf16(s[4 * 33], s[5 * 33]); o.w = cvt_pk_bf16(s[6 * 33], s[7 * 33]);
        *(u32x4*)(WT + (size_t)(n0d + n) * K + k0 + 8 * c) = o; }
    LDS_WAIT(); asm volatile("" ::: "memory");
}
constexpr int TI_IN = (DM / 64) * (INC / 32), TI_OUT = (DM / 64) * (DM / 32), TI_M1 = (DM / 64) * (DFF / 32), TI_M2 = (DFF / 64) * (DM / 32), TI_L = TI_IN + TI_OUT + TI_M1 + TI_M2;
__device__ __forceinline__ void transpose_dispatch(CArgs& a, int l, int r, LAS float* scr, int lane) {
    if (r < TI_IN) { p0_transpose_item<true>(a.in[I_WIN] + (size_t)l * DM * INC, DM, INC, (bf16_t*)(a.ws + WS_WIN) + (size_t)l * DM * INC, scr, r, lane); return; } r -= TI_IN;
    if (r < TI_OUT) { p0_transpose_item<false>(a.in[I_WOUT] + (size_t)l * DM * DM, DM, DM, (bf16_t*)(a.ws + WS_WOUT) + (size_t)l * DM * DM, scr, r, lane); return; } r -= TI_OUT;
    if (r < TI_M1) { p0_transpose_item<false>(a.in[I_WM1] + (size_t)l * DM * DFF, DM, DFF, (bf16_t*)(a.ws + WS_WM1) + (size_t)l * DM * DFF, scr, r, lane); return; } r -= TI_M1;
    p0_transpose_item<false>(a.in[I_WM2] + (size_t)l * DFF * DM, DFF, DM, (bf16_t*)(a.ws + WS_WM2) + (size_t)l * DFF * DM, scr, r, lane);
}
__device__ __forceinline__ void prologue_phase(CArgs& a, LAS unsigned char* lds, int tid, int wave, int lane, int G) {
    LAS float* sc = (LAS float*)lds;
    const float* w_ada = a.in[I_WADA]; float* modp = (float*)(a.ws + WS_MODP);
    for (int it = blockIdx.x; it < 2 * KS_ADA * 6; it += G) {
        const int l = it / (KS_ADA * 6), r = it % (KS_ADA * 6), ks = r / 6, cb = r % 6;
        __syncthreads();
        if (tid < 384) { const int g = tid >> 7, kk = tid & 127, k = 128 * ks + kk; const float cv = (g == 0) ? a.in[I_CCTX][k] : a.in[I_C][(g - 1) * DM + k]; sc[tid] = cv * sigmoidf_fast(cv); }
        __syncthreads();
        const int col = cb * 2048 + tid * 4;
        const float* wp = w_ada + ((size_t)l * DM + 128 * ks) * MODW + col;
        f32x4 a0 = {0.f, 0.f, 0.f, 0.f}, a1 = a0, a2 = a0;
#pragma unroll 8
        for (int kk = 0; kk < 128; ++kk) { const f32x4 w = __builtin_nontemporal_load((const f32x4*)(wp + (size_t)kk * MODW));   a0 += w * sc[kk]; a1 += w * sc[128 + kk]; a2 += w * sc[256 + kk]; }
        float* o = modp + (size_t)((l * KS_ADA + ks) * 3) * MODW + col;
        *(f32x4*)(o) = a0; *(f32x4*)(o + MODW) = a1; *(f32x4*)(o + 2 * MODW) = a2;
    }
    __syncthreads();
    LAS float* scr = (LAS float*)(lds + wave * 16384);
    constexpr int NIT = TI_IN + TI_OUT + TI_M1, NGEMV = 2 * KS_ADA * 6, XL = 7, XH = 15;
    const bool bal = (G == 256) && (NGEMV * 8 * XL + (256 - NGEMV) * 8 * XH == NIT);
    const bool light = (int)blockIdx.x < NGEMV;
    const int gw = blockIdx.x * 8 + wave;
    const int it0 = bal ? (light ? gw : NGEMV * 8 * XL + (gw - NGEMV * 8)) : gw;
    const int its = bal ? (light ? NGEMV * 8 : (256 - NGEMV) * 8) : G * 8;
    const int ite = bal ? (light ? NGEMV * 8 * XL : NIT) : NIT;
    for (int it = it0; it < ite; it += its) transpose_dispatch(a, 0, it, scr, lane);
}
__device__ __forceinline__ void side_transposes(CArgs& a, LAS unsigned char* lds, int lo, int hi, int wave, int lane, int G) {
    const int first = G >> 1; if ((int)blockIdx.x < first) return;
    LAS float* scr = (LAS float*)(lds + wave * 16384);
    for (int it = lo + ((int)blockIdx.x - first) * 8 + wave; it < hi; it += (G - first) * 8) transpose_dispatch(a, it / TI_L, it % TI_L, scr, lane);
}
__device__ __forceinline__ void finmod_phase(CArgs& a, int tid, int G) {
    const float* modp = (const float*)(a.ws + WS_MODP); float* mod = (float*)(a.ws + WS_MOD); const float* b_ada = a.in[I_BADA];
    for (int i = blockIdx.x * 512 + tid; i < 2 * 3 * MODW; i += G * 512) {
        const int l = i / (3 * MODW), r = i % (3 * MODW), g = r / MODW, c = r % MODW;
        float s = b_ada[l * MODW + c];
#pragma unroll
        for (int ks = 0; ks < KS_ADA; ++ks) s += modp[(size_t)((l * KS_ADA + ks) * 3 + g) * MODW + c];
        mod[i] = s;
    }
}

__device__ __forceinline__ const float* xrow_ptr(CArgs& a, int row) {
    return row < NCTX ? a.in[I_XP] + (size_t)row * DM : a.in[I_XS] + (size_t)(row - NCTX) * DM;
}
__device__ __forceinline__ void normmod_phase(CArgs& a, int layer0, const float* __restrict__ gvec, const float* __restrict__ mod, int sh_off, int sc_off, int wave, int lane, int G) {
    bf16_t* hb = (bf16_t*)(a.ws + WS_HB);
    const int gw = blockIdx.x * 8 + wave, NGW = G * 8;
    const int R = ((NTOK + NGW - 1) / NGW + 1) & ~1, rbeg = gw * R, rend = (rbeg + R < NTOK) ? rbeg + R : NTOK;
    int cur_grp = -1; f32x4 A[8], B[8];
    {
        for (int row = rbeg; row < rend; row += 2) {
            const int grp = row / NCTX;
            if (grp != cur_grp) { cur_grp = grp;
#pragma unroll
                for (int j = 0; j < 8; ++j) { const int col = (lane + 64 * (j >> 1)) * 8 + 4 * (j & 1); const f32x4 g4 = *(const f32x4*)(gvec + col), s4 = *(const f32x4*)(mod + grp * MODW + sc_off + col);
                    A[j] = g4 * (s4 + 1.0f); B[j] = *(const f32x4*)(mod + grp * MODW + sh_off + col); } }
            const bool has2 = row + 1 < rend; const int row2 = has2 ? row + 1 : row;
            f32x4 v[8], w2[8]; float ss = 0.f, ss2 = 0.f;
            if (layer0) { const float* s0 = xrow_ptr(a, row); const float* s1 = xrow_ptr(a, row2);
#pragma unroll
                for (int j = 0; j < 8; ++j) { const int col = (lane + 64 * (j >> 1)) * 8 + 4 * (j & 1); v[j] = *(const f32x4*)(s0 + col); w2[j] = *(const f32x4*)(s1 + col); } }
            else { const bf16_t* s0 = (const bf16_t*)(a.ws + WS_XRES) + (size_t)row * DM; const bf16_t* s1 = (const bf16_t*)(a.ws + WS_XRES) + (size_t)row2 * DM;
                u32x4 r0[4], r1[4];
#pragma unroll
                for (int jj = 0; jj < 4; ++jj) { r0[jj] = *(const u32x4*)(s0 + (lane + 64 * jj) * 8); r1[jj] = *(const u32x4*)(s1 + (lane + 64 * jj) * 8); }
#pragma unroll
                for (int jj = 0; jj < 4; ++jj) { float t0[8], t1[8]; unpack8(r0[jj], t0); unpack8(r1[jj], t1);
                    v[2 * jj] = (f32x4){t0[0], t0[1], t0[2], t0[3]}; v[2 * jj + 1] = (f32x4){t0[4], t0[5], t0[6], t0[7]};
                    w2[2 * jj] = (f32x4){t1[0], t1[1], t1[2], t1[3]}; w2[2 * jj + 1] = (f32x4){t1[4], t1[5], t1[6], t1[7]}; } }
#pragma unroll
            for (int j = 0; j < 8; ++j) { ss += (v[j].x * v[j].x + v[j].y * v[j].y) + (v[j].z * v[j].z + v[j].w * v[j].w); ss2 += (w2[j].x * w2[j].x + w2[j].y * w2[j].y) + (w2[j].z * w2[j].z + w2[j].w * w2[j].w); }
            const float rstd = rsqrtf(wave_sum(ss) * (1.0f / DM) + EPS), rstd2 = rsqrtf(wave_sum(ss2) * (1.0f / DM) + EPS);
#pragma unroll
            for (int jj = 0; jj < 4; ++jj) { const f32x4 y0 = v[2 * jj] * rstd * A[2 * jj] + B[2 * jj], y1 = v[2 * jj + 1] * rstd * A[2 * jj + 1] + B[2 * jj + 1];
                *(u32x4*)(hb + (size_t)row * DM + (lane + 64 * jj) * 8) = (u32x4){cvt_pk_bf16(y0.x, y0.y), cvt_pk_bf16(y0.z, y0.w), cvt_pk_bf16(y1.x, y1.y), cvt_pk_bf16(y1.z, y1.w)}; }
            if (has2) {
#pragma unroll
                for (int jj = 0; jj < 4; ++jj) { const f32x4 y0 = w2[2 * jj] * rstd2 * A[2 * jj] + B[2 * jj], y1 = w2[2 * jj + 1] * rstd2 * A[2 * jj + 1] + B[2 * jj + 1];
                    *(u32x4*)(hb + (size_t)row2 * DM + (lane + 64 * jj) * 8) = (u32x4){cvt_pk_bf16(y0.x, y0.y), cvt_pk_bf16(y0.z, y0.w), cvt_pk_bf16(y1.x, y1.y), cvt_pk_bf16(y1.z, y1.w)}; } }
        }
    }
}
__device__ __forceinline__ void final_phase(CArgs& a, int wave, int lane, int G) {
    const float* gvec = a.in[I_FING]; const bf16_t* xres = (const bf16_t*)(a.ws + WS_XRES);
    const int gw = blockIdx.x * 8 + wave, NGW = G * 8;
    f32x4 A[8];
#pragma unroll
    for (int j = 0; j < 8; ++j) A[j] = *(const f32x4*)(gvec + (lane + 64 * (j >> 1)) * 8 + 4 * (j & 1));
    for (int row = gw; row < NTOK; row += 3 * NGW) {
        int rr[3]; bool ok[3];
#pragma unroll
        for (int k = 0; k < 3; ++k) { ok[k] = row + k * NGW < NTOK; rr[k] = ok[k] ? row + k * NGW : row; }
        u32x4 r[3][4];
#pragma unroll
        for (int k = 0; k < 3; ++k)
#pragma unroll
            for (int jj = 0; jj < 4; ++jj) r[k][jj] = *(const u32x4*)(xres + (size_t)rr[k] * DM + (lane + 64 * jj) * 8);
#pragma unroll
        for (int k = 0; k < 3; ++k) {
            f32x4 v[8]; float ss = 0.f;
#pragma unroll
            for (int jj = 0; jj < 4; ++jj) { float t8[8]; unpack8(r[k][jj], t8); v[2 * jj] = (f32x4){t8[0], t8[1], t8[2], t8[3]}; v[2 * jj + 1] = (f32x4){t8[4], t8[5], t8[6], t8[7]}; }
#pragma unroll
            for (int j = 0; j < 8; ++j) ss += (v[j].x * v[j].x + v[j].y * v[j].y) + (v[j].z * v[j].z + v[j].w * v[j].w);
            const float rstd = rsqrtf(wave_sum(ss) * (1.0f / DM) + EPS);
            if (ok[k]) {
#pragma unroll
                for (int j = 0; j < 8; ++j) *(f32x4*)(a.out + (size_t)rr[k] * DM + (lane + 64 * (j >> 1)) * 8 + 4 * (j & 1)) = v[j] * rstd * A[j]; }
        }
    }
}

constexpr int H_LF = 0, H_SQ = 16384, H_KK = 32768, H_QT = 49152, H_KT = 57856, H_KPT = 66560, H_VT = 76800  , H_PM = 97280, H_DD = 99840, H_OT = 100352  , H_LB = 117248  ;
constexpr int QS = 136;
constexpr int TS = 40;
constexpr int OTS = 132;
constexpr int VRS = 132;

__device__ __forceinline__ void hgrn_phase(CArgs& a, LAS unsigned char* lds, int l, int pass, int tid, int wave, int lane, int G) {
    const bf16_t* __restrict__ proj = (const bf16_t*)(a.ws + WS_PROJ);
    float* segL = (float*)(a.ws + WS_SEGL); float* segD = (float*)(a.ws + WS_SEGD);
    LAS float* LF = (LAS float*)(lds + H_LF); LAS bf16_t* SQR = (LAS bf16_t*)(lds + H_SQ);
    LAS bf16_t* QT = (LAS bf16_t*)(lds + H_QT); LAS bf16_t* KT = (LAS bf16_t*)(lds + H_KT); LAS bf16_t* KPT = (LAS bf16_t*)(lds + H_KPT);
    LAS bf16_t* PM = (LAS bf16_t*)(lds + H_PM); LAS float* DD = (LAS float*)(lds + H_DD); LAS float* OT = (LAS float*)(lds + H_OT); LAS float* LBV = (LAS float*)(lds + H_LB);
    const int n16 = lane & 15, kg = lane >> 4;
    const int tok = tid >> 4, c8 = tid & 15;
    const int dk = tid & 127, tq = wave >> 1;
    for (int i = tid; i < 32 * TS; i += 512) PM[i] = 0;
    const int nlat = (pass == 1) ? 32 * (NSEG - 1) : 32 * NSEG;
    const int nitems = (pass == 1) ? nlat : nlat + 256;
    for (int item = blockIdx.x; item < nitems; item += G) {
        int b, h, dir, T0, L, c0, nch, seg = 0, chain = 0; bool lat;
        if (item < nlat) { lat = true; const int ns = (pass == 1) ? (NSEG - 1) : NSEG; chain = item / ns; seg = item % ns; b = chain >> 4; h = (chain >> 1) & 7; dir = chain & 1; T0 = NCTX + b * 4096; L = 4096; c0 = seg * SEGCH; nch = SEGCH; }
        else { lat = false; const int j = item - nlat; b = j >> 4; h = (j >> 1) & 7; dir = j & 1; T0 = b * 256; L = 256; c0 = 0; nch = 8; }
        const bool want_out = (pass == 3);
        bf16_t* __restrict__ ofd = (bf16_t*)(a.ws + WS_OF) + (size_t)dir * NTOK * HW;
        u32x4 rq, rz, rv;
        { const int p = 32 * c0 + tok; const int row = T0 + (dir ? (L - 1 - p) : p); const bf16_t* bp = proj + (size_t)row * INC + h * 128 + c8 * 8;
          rq = *(const u32x4*)(bp); rv = *(const u32x4*)(bp + 1024); rz = *(const u32x4*)(bp + 2048 + dir * 1024); }
        __syncthreads();
        if (tid < 128) { float v = 0.f; if (l != 0) { const float l0 = a.in[I_LB][(0 * 2 + dir) * HW + h * 128 + tid], l1 = a.in[I_LB][(1 * 2 + dir) * HW + h * 128 + tid]; v = __builtin_amdgcn_rcpf(1.0f + __expf(l0 - l1)); } LBV[tid] = v; }
        f32x4 S[8];
#pragma unroll
        for (int t = 0; t < 8; ++t) S[t] = (f32x4){0.f, 0.f, 0.f, 0.f};
        if (lat && pass == 3) {
            const float* s0 = a.in[I_STATE] + ((size_t)(((b * 2 + l) * 2 + dir) * 8 + h)) * 16384 + wave * 16 + n16;
#pragma unroll
            for (int t = 0; t < 8; ++t)
#pragma unroll
                for (int j = 0; j < 4; ++j) S[t][j] = s0[(16 * t + 4 * kg + j) * 128];
            asm volatile("" ::: "memory");
#pragma unroll 2
            for (int sj = 0; sj < seg; ++sj) {
                const float* Lp = segL + (size_t)(chain * NSEG + sj) * 16384 + tid * 4; const float* Dp = segD + (size_t)(chain * NSEG + sj) * 128;
#pragma unroll
                for (int t = 0; t < 8; ++t) { const f32x4 d4 = *(const f32x4*)(Dp + 16 * t + 4 * kg); S[t] = S[t] * d4 + *(const f32x4*)(Lp + t * 2048); }
            }
        }
        float dprod = 1.f;
        __syncthreads();
#pragma unroll 1
        for (int ci = 0; ci < nch; ++ci) {
            const int c = c0 + ci;
            LAS bf16_t* VR = (LAS bf16_t*)(lds + H_VT + (ci & 1) * 10240);
            {
                float zf[8]; unpack8(rz, zf);
                float lf[8], lb[8];
                if (l != 0) { const f32x4 b0 = *(const LAS f32x4*)(LBV + c8 * 8), b1 = *(const LAS f32x4*)(LBV + c8 * 8 + 4); lb[0] = b0.x; lb[1] = b0.y; lb[2] = b0.z; lb[3] = b0.w; lb[4] = b1.x; lb[5] = b1.y; lb[6] = b1.z; lb[7] = b1.w; }
                else {
#pragma unroll
                    for (int i = 0; i < 8; ++i) lb[i] = 0.f; }
#pragma unroll
                for (int i = 0; i < 8; ++i) {
                    const float sg = __builtin_amdgcn_rcpf(1.0f + __builtin_amdgcn_exp2f(zf[i] * -1.44269504f));
                    lf[i] = (l != 0) ? lb[i] + (1.0f - lb[i]) * sg : sg;
                }
                const int o = tok * 128 + c8 * 8;
                *(LAS f32x4*)(LF + o) = (f32x4){lf[0], lf[1], lf[2], lf[3]}; *(LAS f32x4*)(LF + o + 4) = (f32x4){lf[4], lf[5], lf[6], lf[7]};
                if (want_out) *(LAS u32x4*)(SQR + o) = rq;
                *(LAS u32x2*)(VR + tok * VRS + c8 * 8) = (u32x2){rv.x, rv.y}; *(LAS u32x2*)(VR + tok * VRS + c8 * 8 + 4) = (u32x2){rv.z, rv.w};
            }
            if (ci + 1 < nch) { const int p = 32 * (c + 1) + tok; const int row = T0 + (dir ? (L - 1 - p) : p); const bf16_t* bp = proj + (size_t)row * INC + h * 128 + c8 * 8;
                rq = *(const u32x4*)(bp); rv = *(const u32x4*)(bp + 1024); rz = *(const u32x4*)(bp + 2048 + dir * 1024); }
            LBAR();
            if (want_out && ci > 0) {
                const int p = 32 * (c - 1) + tok; const int row = T0 + (dir ? (L - 1 - p) : p); bf16_t* op = ofd + (size_t)row * HW + h * 128 + c8 * 8;
                { const f32x4 x0 = *(const LAS f32x4*)(OT + tok * OTS + c8 * 8), x1 = *(const LAS f32x4*)(OT + tok * OTS + c8 * 8 + 4);
                  *(u32x4*)(op) = (u32x4){cvt_pk_bf16(x0.x, x0.y), cvt_pk_bf16(x0.z, x0.w), cvt_pk_bf16(x1.x, x1.y), cvt_pk_bf16(x1.z, x1.w)}; }
            }
            {
                float g4[4];
#pragma unroll
                for (int k = 0; k < 4; ++k) { float s = 1.f;
#pragma unroll
                    for (int j = 0; j < 8; ++j) s *= LF[(8 * k + j) * 128 + dk];
                    g4[k] = s; }
                const float dlast = (g4[0] * g4[1]) * (g4[2] * g4[3]);
                const float pre = (tq > 0 ? g4[0] : 1.f) * (tq > 1 ? g4[1] : 1.f) * (tq > 2 ? g4[2] : 1.f);
                const float post = (tq < 3 ? g4[3] : 1.f) * (tq < 2 ? g4[2] : 1.f) * (tq < 1 ? g4[1] : 1.f);
                float own[8], pfx[8], sfx[8];
#pragma unroll
                for (int j = 0; j < 8; ++j) own[j] = LF[(8 * tq + j) * 128 + dk];
                { float run = pre;
#pragma unroll
                  for (int j = 0; j < 8; ++j) { run *= own[j]; pfx[j] = run; }
                  run = post;
#pragma unroll
                  for (int j = 7; j >= 0; --j) { sfx[j] = run; run *= own[j]; } }
                float kp[8]; const float rdl = fminf(__builtin_amdgcn_rcpf(dlast), 1e34f);
#pragma unroll
                for (int j = 0; j < 8; ++j) { const int r = 8 * tq + j; const float k = 1.0f - own[j];
                    kp[j] = k * sfx[j];
                    if (want_out) { const float s = bf2f(SQR[r * 128 + dk]);
                        QT[r * QS + dk] = f2bf(s * pfx[j]); KT[r * QS + dk] = f2bf(kp[j] * rdl); } }
                u32x4 w; w.x = cvt_pk_bf16(kp[0], kp[1]); w.y = cvt_pk_bf16(kp[2], kp[3]); w.z = cvt_pk_bf16(kp[4], kp[5]); w.w = cvt_pk_bf16(kp[6], kp[7]);
                *(LAS u32x4*)(KPT + dk * TS + 8 * tq) = w;
                if (tq == 0) DD[dk] = dlast;
                dprod *= dlast;
            }
            LBAR();
            if (want_out) {
                if (wave < 3) {
                    const int mi = wave > 0 ? 1 : 0, ni = wave > 1 ? 1 : 0;
                    f32x4 pacc = {0.f, 0.f, 0.f, 0.f};
#pragma unroll
                    for (int ks = 0; ks < 4; ++ks) { const bf16x8 av = *(const LAS bf16x8*)(QT + (16 * mi + n16) * QS + 32 * ks + 8 * kg), bv = *(const LAS bf16x8*)(KT + (16 * ni + n16) * QS + 32 * ks + 8 * kg);
                        pacc = __builtin_amdgcn_mfma_f32_16x16x32_bf16(av, bv, pacc, 0, 0, 0); }
#pragma unroll
                    for (int j = 0; j < 4; ++j) { const int t = 16 * mi + 4 * kg + j, s = 16 * ni + n16; PM[t * TS + s] = f2bf(s <= t ? pacc[j] : 0.f); }
                }
                LBAR();
            }
            {
                bf16x8 vb;
                { const LAS bf16_t* vp = VR + (8 * kg) * VRS + 16 * wave + n16;
                  const u32x4 vw = {(unsigned)vp[0] | ((unsigned)vp[VRS] << 16), (unsigned)vp[2 * VRS] | ((unsigned)vp[3 * VRS] << 16), (unsigned)vp[4 * VRS] | ((unsigned)vp[5 * VRS] << 16), (unsigned)vp[6 * VRS] | ((unsigned)vp[7 * VRS] << 16)};
                  vb = __builtin_bit_cast(bf16x8, vw); }
                if (want_out) {
                    f32x4 o0 = {0.f, 0.f, 0.f, 0.f}, o1 = o0;
#pragma unroll
                    for (int ks = 0; ks < 4; ++ks) {
                        u32x4 sb; sb.x = cvt_pk_bf16(S[2 * ks][0], S[2 * ks][1]); sb.y = cvt_pk_bf16(S[2 * ks][2], S[2 * ks][3]); sb.z = cvt_pk_bf16(S[2 * ks + 1][0], S[2 * ks + 1][1]); sb.w = cvt_pk_bf16(S[2 * ks + 1][2], S[2 * ks + 1][3]);
                        const bf16x8 sbv = __builtin_bit_cast(bf16x8, sb);
                        u32x2 a0l = *(const LAS u32x2*)(QT + n16 * QS + 32 * ks + 4 * kg), a0h = *(const LAS u32x2*)(QT + n16 * QS + 32 * ks + 16 + 4 * kg);
                        u32x2 a1l = *(const LAS u32x2*)(QT + (16 + n16) * QS + 32 * ks + 4 * kg), a1h = *(const LAS u32x2*)(QT + (16 + n16) * QS + 32 * ks + 16 + 4 * kg);
                        const u32x4 A0 = {a0l.x, a0l.y, a0h.x, a0h.y}, A1 = {a1l.x, a1l.y, a1h.x, a1h.y};
                        o0 = __builtin_amdgcn_mfma_f32_16x16x32_bf16(__builtin_bit_cast(bf16x8, A0), sbv, o0, 0, 0, 0);
                        o1 = __builtin_amdgcn_mfma_f32_16x16x32_bf16(__builtin_bit_cast(bf16x8, A1), sbv, o1, 0, 0, 0);
                    }
                    const bf16x8 p0 = *(const LAS bf16x8*)(PM + n16 * TS + 8 * kg), p1 = *(const LAS bf16x8*)(PM + (16 + n16) * TS + 8 * kg);
                    o0 = __builtin_amdgcn_mfma_f32_16x16x32_bf16(p0, vb, o0, 0, 0, 0);
                    o1 = __builtin_amdgcn_mfma_f32_16x16x32_bf16(p1, vb, o1, 0, 0, 0);
#pragma unroll
                    for (int j = 0; j < 4; ++j) { OT[(4 * kg + j) * OTS + 16 * wave + n16] = o0[j]; OT[(16 + 4 * kg + j) * OTS + 16 * wave + n16] = o1[j]; }
                }
#pragma unroll
                for (int t = 0; t < 8; ++t) {
                    const f32x4 d4 = *(const LAS f32x4*)(DD + 16 * t + 4 * kg);
                    const bf16x8 ka = *(const LAS bf16x8*)(KPT + (16 * t + n16) * TS + 8 * kg);
                    S[t] = __builtin_amdgcn_mfma_f32_16x16x32_bf16(ka, vb, S[t] * d4, 0, 0, 0);
                }
            }
        }
        if (want_out) {
            __syncthreads();
            const int p = 32 * (c0 + nch - 1) + tok; const int row = T0 + (dir ? (L - 1 - p) : p); bf16_t* op = ofd + (size_t)row * HW + h * 128 + c8 * 8;
            { const f32x4 x0 = *(const LAS f32x4*)(OT + tok * OTS + c8 * 8), x1 = *(const LAS f32x4*)(OT + tok * OTS + c8 * 8 + 4);
              *(u32x4*)(op) = (u32x4){cvt_pk_bf16(x0.x, x0.y), cvt_pk_bf16(x0.z, x0.w), cvt_pk_bf16(x1.x, x1.y), cvt_pk_bf16(x1.z, x1.w)}; }
        }
        if (pass == 1) {
            float* Lp = segL + (size_t)(chain * NSEG + seg) * 16384 + tid * 4;
#pragma unroll
            for (int t = 0; t < 8; ++t) *(f32x4*)(Lp + t * 2048) = S[t];
            if (tq == 0) segD[(size_t)(chain * NSEG + seg) * 128 + dk] = dprod;
        } else if (!lat) {
            float* sp = a.out + (size_t)NTOK * DM + ((size_t)(((b * 2 + l) * 2 + dir) * 8 + h)) * 16384 + wave * 16 + n16;
#pragma unroll
            for (int t = 0; t < 8; ++t)
#pragma unroll
                for (int j = 0; j < 4; ++j) sp[(16 * t + 4 * kg + j) * 128] = S[t][j];
        }
    }
}

__device__ __forceinline__ void combine_phase(CArgs& a, int l, int wave, int lane, int G) {
    const bf16_t* __restrict__ proj = (const bf16_t*)(a.ws + WS_PROJ);
    const bf16_t* __restrict__ of = (const bf16_t*)(a.ws + WS_OF); const bf16_t* __restrict__ ob = of + (size_t)NTOK * HW;
    bf16_t* hb = (bf16_t*)(a.ws + WS_HB);
    const float* hgg = a.in[I_HGG] + l * HW + 16 * lane; const float* cw = a.in[I_CONVW] + l * 3 * HW + 16 * lane;
    const int gw = blockIdx.x * 8 + wave, NGW = G * 8;
    for (int t = gw; t < NTOK; t += NGW) {
        float o[16]; float ss = 0.f;
#pragma unroll
        for (int q = 0; q < 2; ++q) { float xf[8], xb[8]; unpack8(*(const u32x4*)(of + (size_t)t * HW + 16 * lane + 8 * q), xf); unpack8(*(const u32x4*)(ob + (size_t)t * HW + 16 * lane + 8 * q), xb);
#pragma unroll
            for (int i = 0; i < 8; ++i) { const float x = xf[i] + xb[i]; o[8 * q + i] = x; ss += x * x; } }
        ss += __shfl_xor(ss, 1); ss += __shfl_xor(ss, 2); ss += __shfl_xor(ss, 4);
        const float rstd = rsqrtf(ss * (1.0f / 128.0f) + EPS);
        const bf16_t* pr = proj + (size_t)t * INC + 16 * lane;
        float gf[16]; { float t8[8]; unpack8(*(const u32x4*)(pr + 4096), t8); for (int i = 0; i < 8; ++i) gf[i] = t8[i]; unpack8(*(const u32x4*)(pr + 4096 + 8), t8); for (int i = 0; i < 8; ++i) gf[8 + i] = t8[i]; }
        unsigned w[8];
#pragma unroll
        for (int i = 0; i < 8; ++i) { const float y0 = o[2 * i] * rstd * hgg[2 * i] * (gf[2 * i] * sigmoidf_fast(gf[2 * i])), y1 = o[2 * i + 1] * rstd * hgg[2 * i + 1] * (gf[2 * i + 1] * sigmoidf_fast(gf[2 * i + 1])); w[i] = cvt_pk_bf16(y0, y1); }
        *(u32x4*)(hb + (size_t)t * DM + 16 * lane) = (u32x4){w[0], w[1], w[2], w[3]}; *(u32x4*)(hb + (size_t)t * DM + 16 * lane + 8) = (u32x4){w[4], w[5], w[6], w[7]};
        int st; bool hp, hn;
        if (t < NCTX) { const int i = t & 255; st = 1; hp = i != 0; hn = i != 255; }
        else { const int i = (t - NCTX) & 4095; if ((l & 1) == 0) { const int cc = i & 63; st = 1; hp = cc != 0; hn = cc != 63; } else { st = 64; hp = i >= 64; hn = i < 4096 - 64; } }
        float uc[16], up[16], un[16], bb[16];
        { float x8[8];
#pragma unroll
          for (int hlf = 0; hlf < 2; ++hlf) {
            unpack8(*(const u32x4*)(pr + 6144 + 8 * hlf), x8);
#pragma unroll
            for (int i = 0; i < 8; ++i) uc[8 * hlf + i] = x8[i];
            if (hp) { unpack8(*(const u32x4*)(pr - (size_t)st * INC + 6144 + 8 * hlf), x8);
#pragma unroll
                for (int i = 0; i < 8; ++i) up[8 * hlf + i] = x8[i]; }
            else {
#pragma unroll
                for (int i = 0; i < 8; ++i) up[8 * hlf + i] = 0.f; }
            if (hn) { unpack8(*(const u32x4*)(pr + (size_t)st * INC + 6144 + 8 * hlf), x8);
#pragma unroll
                for (int i = 0; i < 8; ++i) un[8 * hlf + i] = x8[i]; }
            else {
#pragma unroll
                for (int i = 0; i < 8; ++i) un[8 * hlf + i] = 0.f; }
            unpack8(*(const u32x4*)(pr + 5120 + 8 * hlf), x8);
#pragma unroll
            for (int i = 0; i < 8; ++i) bb[8 * hlf + i] = x8[i];
          } }
#pragma unroll
        for (int i = 0; i < 8; ++i) {
            const float y0 = bb[2 * i] * (cw[2 * i] * up[2 * i] + cw[HW + 2 * i] * uc[2 * i] + cw[2 * HW + 2 * i] * un[2 * i]);
            const float y1 = bb[2 * i + 1] * (cw[2 * i + 1] * up[2 * i + 1] + cw[HW + 2 * i + 1] * uc[2 * i + 1] + cw[2 * HW + 2 * i + 1] * un[2 * i + 1]);
            w[i] = cvt_pk_bf16(y0, y1); }
        *(u32x4*)(hb + (size_t)t * DM + HW + 16 * lane) = (u32x4){w[0], w[1], w[2], w[3]}; *(u32x4*)(hb + (size_t)t * DM + HW + 16 * lane + 8) = (u32x4){w[4], w[5], w[6], w[7]};
    }
}

#define XB_TMO      128
#define XB_XCNT(j)  (256  + 64 * (j))
#define XB_XSUB(j)  (1280 + 64 * (j))
#define XB_XGEN(j)  (2304 + 64 * (j))
#define XB_TOP      3328
#define XB_TOPGEN   3392
#define XCD_BAR_WORDS 3456
#define SPLIT_FLAG_BASE 4096
#define CTL_WORDS (4096 + 4 * 128 * 16)
#define XB_SPIN_CAP (1u << 22)
__device__ __forceinline__ unsigned xb_ld(unsigned* p)              { return __hip_atomic_load(p, __ATOMIC_RELAXED, __HIP_MEMORY_SCOPE_AGENT); }
__device__ __forceinline__ unsigned xb_add(unsigned* p, unsigned v) { return __hip_atomic_fetch_add(p, v, __ATOMIC_RELAXED, __HIP_MEMORY_SCOPE_AGENT); }
__device__ __forceinline__ unsigned xb_xcc_id() { return (unsigned)__builtin_amdgcn_s_getreg((3 << 11) | 20) & 0xFu; }
#define XB_SPIN(cond, bar) do { unsigned _sp = 0; while (cond) { __builtin_amdgcn_s_sleep(1); \
    if ((++_sp & 255u) == 0u) { if (xb_ld(&(bar)[XB_TMO])) break; if (_sp > XB_SPIN_CAP) { atomicAdd(&(bar)[XB_TMO], 1u); break; } } } } while (0)
struct XcdBarrier { unsigned* bar; unsigned x; volatile LAS unsigned* st; };
__device__ __forceinline__ XcdBarrier xcd_barrier_post(unsigned* bar, volatile LAS unsigned* st) {
    XcdBarrier b; b.bar = bar; b.x = xb_xcc_id(); b.st = st;
    if (threadIdx.x == 0) (void)xb_add(&bar[XB_XCNT(b.x)], 1u);
    return b;
}
__device__ __forceinline__ void xcd_barrier_complete(unsigned* bar, unsigned x, unsigned& nloc, unsigned& nx) {
    const unsigned G = gridDim.x * gridDim.y * gridDim.z;
    unsigned sum, cnt, mine, sp = 0u;
    for (;;) {
        sum = 0u; cnt = 0u; mine = 0u;
#pragma unroll
        for (unsigned j = 0; j < 16; ++j) { const unsigned c = xb_ld(&bar[XB_XCNT(j)]); sum += c; cnt += (c > 0u) ? 1u : 0u; mine = (j == x) ? c : mine; }
        if (sum == G) break;
        __builtin_amdgcn_s_sleep(1);
        if ((++sp & 255u) == 0u) { if (xb_ld(&bar[XB_TMO])) break; if (sp > XB_SPIN_CAP) { atomicAdd(&bar[XB_TMO], 1u); break; } }
    }
    nloc = mine > 0u ? mine : 1u; nx = cnt > 0u ? cnt : 1u;
}
__device__ __forceinline__ void xcd_barrier(const XcdBarrier& b) {
    asm volatile("s_waitcnt vmcnt(0)" ::: "memory");
    __syncthreads();
    if (threadIdx.x == 0) {
        unsigned* bar = b.bar;
        __builtin_amdgcn_s_waitcnt(0);
        unsigned nloc = b.st[0], nx = b.st[1];
        if (nloc == 0u) { xcd_barrier_complete(bar, b.x, nloc, nx); b.st[0] = nloc; b.st[1] = nx; }
        const unsigned old = xb_add(&bar[XB_XSUB(b.x)], 1u);
        const unsigned gen = old / nloc;
        if (old + 1u == (gen + 1u) * nloc) {
            __builtin_amdgcn_fence(__ATOMIC_RELEASE, "agent");
            asm volatile("s_waitcnt vmcnt(0)" ::: "memory");
            const unsigned og = xb_add(&bar[XB_TOP], 1u);
            const unsigned tg = og / nx;
            if (og + 1u == (tg + 1u) * nx) xb_add(&bar[XB_TOPGEN], 1u);
            else XB_SPIN(xb_ld(&bar[XB_TOPGEN]) == tg, bar);
            __builtin_amdgcn_fence(__ATOMIC_ACQUIRE, "agent");
            xb_add(&bar[XB_XGEN(b.x)], 1u);
            asm volatile("s_waitcnt vmcnt(0)" ::: "memory");
        } else {
            XB_SPIN(xb_ld(&bar[XB_XGEN(b.x)]) == gen, bar);
            __builtin_amdgcn_fence(__ATOMIC_ACQUIRE, "agent");
            asm volatile("s_waitcnt vmcnt(0)" ::: "memory");
        }
    }
    __syncthreads();
}

__global__ void __launch_bounds__(512, 2) fwd_kernel(Args a) {
    extern __shared__ __attribute__((aligned(16))) unsigned char lds_raw[];
    LAS unsigned char* lds = (LAS unsigned char*)lds_raw;
    const int G = gridDim.x;
    cg::grid_group grid = cg::this_grid();
#define HB ((bf16_t*)(a.ws + WS_HB))
#define PROJ ((bf16_t*)(a.ws + WS_PROJ))
#define XRES ((bf16_t*)(a.ws + WS_XRES))
#define PH(p) (a.ph_lo <= (p) && (p) < a.ph_hi)
#define TIDS() CArgs* lap_ = (CArgs*)__builtin_amdgcn_kernarg_segment_ptr(); asm volatile("" : "+s"(lap_)); CArgs& a = *lap_; int tid = threadIdx.x; asm volatile("" : "+v"(tid)); const int lane = tid & 63, wave = __builtin_amdgcn_readfirstlane(tid >> 6); (void)lane; (void)wave
    volatile LAS unsigned* bst = (volatile LAS unsigned*)(lds + LDS_BYTES - 64);
    if (threadIdx.x == 0) { bst[0] = 0u; bst[1] = 0u; }
    unsigned* barw = (unsigned*)(a.ws + WS_BAR);
    const bool single = (a.ph_hi - a.ph_lo) > 1;
    __syncthreads();
    XcdBarrier xbar; xbar.bar = barw; xbar.x = 0; xbar.st = bst;
    if (single) xbar = xcd_barrier_post(barw, bst);
    if (a.ph_hi < 0) grid.sync();
#define SEAM(p) do { if ((p) + 1 < a.ph_hi) xcd_barrier(xbar); } while (0)
    if (PH(0)) { TIDS(); for (int rep = 0; rep < REP_PRO; ++rep) prologue_phase(a, lds, tid, wave, lane, G); SEAM(0); }
    if (PH(1)) { TIDS(); finmod_phase(a, tid, G); SEAM(1); }
#pragma unroll
    for (int l = 0; l < 2; ++l) {
        const int p0 = 2 + 9 * l;
#define mod ((const float*)(a.ws + WS_MOD) + (size_t)l * 3 * MODW)
        if (PH(p0 + 0)) { TIDS(); for (int rep = 0; rep < REP_MISC; ++rep) normmod_phase(a, l == 0, a.in[I_N1G] + l * DM, mod, 0 * DM, 1 * DM, wave, lane, G); SEAM(p0 + 0); }
        if (PH(p0 + 1)) { TIDS(); pg8::Gemm g{HB, (const bf16_t*)(a.ws + WS_WIN) + (size_t)l * DM * INC, NTOK, INC, DM, nullptr, nullptr}; pg8::StaticOrder S; S.init(NTOK, INC, DM, G, (int)blockIdx.x);
                  pg8::EpiBf16<0> E{PROJ, INC}; for (int rep = 0; rep < REP_GBIG; ++rep) pg8::gemm_phase<decltype(E), pg8::StaticOrder, false>(lds, g, S, E, tid); SEAM(p0 + 1); }
        if (PH(p0 + 2)) { TIDS(); if (NSEG > 1) for (int rep = 0; rep < REP_H1; ++rep) hgrn_phase(a, lds, l, 1, tid, wave, lane, G); SEAM(p0 + 2); }
        if (PH(p0 + 3)) { TIDS(); for (int rep = 0; rep < REP_HG; ++rep) hgrn_phase(a, lds, l, 3, tid, wave, lane, G); SEAM(p0 + 3); }
        if (PH(p0 + 4)) { TIDS(); for (int rep = 0; rep < REP_CB; ++rep) combine_phase(a, l, wave, lane, G); SEAM(p0 + 4); }
        if (PH(p0 + 5)) { TIDS(); pg8::Gemm g{HB, (const bf16_t*)(a.ws + WS_WOUT) + (size_t)l * DM * DM, NTOK, DM, DM, (float*)(a.ws + WS_PART), (unsigned*)(a.ws + WS_BAR) + SPLIT_FLAG_BASE + (l * 2 + 0) * 2048}; pg8::StaticOrder S; S.init(NTOK, DM, DM, G, (int)blockIdx.x);
                  pg8::EpiRes E{a.in[I_XP], a.in[I_XS], XRES, XRES, mod, 2 * DM, l == 0}; pg8::gemm_phase<pg8::EpiRes, pg8::StaticOrder, false>(lds, g, S, E, tid);
                  side_transposes(a, lds, l * TI_L + TI_IN + TI_OUT + TI_M1, (l + 1) * TI_L, wave, lane, G); SEAM(p0 + 5); }
        if (PH(p0 + 6)) { TIDS(); for (int rep = 0; rep < REP_MISC; ++rep) normmod_phase(a, 0, a.in[I_N2G] + l * DM, mod, 3 * DM, 4 * DM, wave, lane, G); SEAM(p0 + 6); }
        if (PH(p0 + 7)) { TIDS(); pg8::Gemm g{HB, (const bf16_t*)(a.ws + WS_WM1) + (size_t)l * DM * DFF, NTOK, DFF, DM, nullptr, nullptr}; pg8::StaticOrder S; S.init(NTOK, DFF, DM, G, (int)blockIdx.x);
                  pg8::EpiBf16<1> E{PROJ, DFF}; for (int rep = 0; rep < REP_GBIG; ++rep) pg8::gemm_phase<decltype(E), pg8::StaticOrder, false>(lds, g, S, E, tid); SEAM(p0 + 7); }
        if (PH(p0 + 8)) { TIDS(); pg8::Gemm g{PROJ, (const bf16_t*)(a.ws + WS_WM2) + (size_t)l * DFF * DM, NTOK, DM, DFF, (float*)(a.ws + WS_PART), (unsigned*)(a.ws + WS_BAR) + SPLIT_FLAG_BASE + (l * 2 + 1) * 2048}; pg8::StaticOrder S; S.init(NTOK, DM, DFF, G, (int)blockIdx.x);
                  pg8::EpiRes E{a.in[I_XP], a.in[I_XS], XRES, XRES, mod, 5 * DM, 0}; pg8::gemm_phase<pg8::EpiRes, pg8::StaticOrder, false>(lds, g, S, E, tid);
                  if (l == 0) side_transposes(a, lds, TI_L, 2 * TI_L - TI_M2, wave, lane, G); SEAM(p0 + 8); }
    }
    if (PH(20)) { TIDS(); for (int rep = 0; rep < REP_MISC; ++rep) final_phase(a, wave, lane, G); }
}

extern "C" void kernel_launch(void* const* d_in, const int* in_sizes, int n_in, void* d_out, int out_size, void* d_ws, size_t ws_size, hipStream_t stream) {
    static int grid = 0;
    if (grid == 0) {
        if (n_in != 17 || ws_size < WS_END) { fprintf(stderr, "kernel_launch: expected 17 inputs and >= %zu bytes of workspace, got %d / %zu\n", (size_t)WS_END, n_in, ws_size); grid = -1; return; }
        int dev = 0, cus = 0, per_cu = 0;
        hipGetDevice(&dev); hipDeviceGetAttribute(&cus, hipDeviceAttributeMultiprocessorCount, dev);
        if (hipFuncSetAttribute((const void*)fwd_kernel, hipFuncAttributeMaxDynamicSharedMemorySize, LDS_BYTES) != hipSuccess) { fprintf(stderr, "kernel_launch: hipFuncSetAttribute failed\n"); grid = -1; return; }
        if (hipOccupancyMaxActiveBlocksPerMultiprocessor(&per_cu, (const void*)fwd_kernel, 512, LDS_BYTES) != hipSuccess || per_cu < 1) { fprintf(stderr, "kernel_launch: occupancy query gave %d\n", per_cu); per_cu = 1; }
        (void)hipGetLastError();
        grid = cus * per_cu;
        fprintf(stderr, "kernel_launch: grid %d (%d CUs x %d)\n", grid, cus, per_cu);
    }
    if (grid < 0) return;
    Args a{};
    for (int i = 0; i < 17; ++i) a.in[i] = (const float*)d_in[i];
    a.out = (float*)d_out; a.ws = (unsigned char*)d_ws;
#if MK_SINGLE
    a.ph_lo = 0; a.ph_hi = NPHASE;
    if (hipMemsetAsync((char*)d_ws + WS_BAR, 0, (size_t)CTL_WORDS * 4, stream) != hipSuccess) { fprintf(stderr, "kernel_launch: memset of the barrier words failed\n"); return; }
    void* args[] = {&a};
    hipError_t e = hipLaunchCooperativeKernel((const void*)fwd_kernel, dim3(grid), dim3(512), args, LDS_BYTES, stream);
    if (e != hipSuccess) fprintf(stderr, "cooperative launch failed: %s (grid %d)\n", hipGetErrorString(e), grid);
#else
    for (int ph = 0; ph < NPHASE; ++ph) {
        if (NSEG == 1 && (ph == 4 || ph == 13)) continue;
        a.ph_lo = ph; a.ph_hi = ph + 1;
        hipLaunchKernelGGL(fwd_kernel, dim3(grid), dim3(512), LDS_BYTES, stream, a);
    }
#endif
}
```

```cpp
#include <hip/hip_runtime.h>
#include <hip/hip_cooperative_groups.h>
#include <cstdio>
namespace cg = cooperative_groups;

#ifndef REP_GBIG
#define REP_GBIG 1
#endif
#ifndef REP_HG
#define REP_HG 1
#endif
#ifndef REP_MISC
#define REP_MISC 1
#endif
#ifndef REP_PRO
#define REP_PRO 1
#endif
#ifndef REP_CB
#define REP_CB 1
#endif
#ifndef REP_H1
#define REP_H1 1
#endif
#ifndef MK_SINGLE
#define MK_SINGLE 1
#endif

#define LAS __attribute__((address_space(3)))
typedef unsigned short bf16_t;
typedef short bf16x8 __attribute__((ext_vector_type(8)));
typedef short bf16x4 __attribute__((ext_vector_type(4)));
typedef float f32x4 __attribute__((ext_vector_type(4)));
typedef unsigned u32x4 __attribute__((ext_vector_type(4)));
typedef unsigned u32x2 __attribute__((ext_vector_type(2)));

constexpr int DM = 2048, NCTX = 4096, NTOK = 12288, HW = 1024, INC = 8192, DFF = 8192, MODW = 12288;
constexpr int NSEG = 8;
constexpr int SEGCH = 128 / NSEG;
constexpr float EPS = 1e-6f;
constexpr int KS_ADA = 16;
constexpr int NPHASE = 21;
constexpr int LDS_BYTES = 135168;

constexpr size_t MiB = 1u << 20;
constexpr size_t WS_WIN = 0;
constexpr size_t WS_WOUT = 64 * MiB;
constexpr size_t WS_WM1 = 80 * MiB;
constexpr size_t WS_WM2 = 144 * MiB;
constexpr size_t WS_XRES = 208 * MiB;
constexpr size_t WS_HB = 304 * MiB;
constexpr size_t WS_PROJ = 352 * MiB;
constexpr size_t WS_OF = 544 * MiB;
constexpr size_t WS_MODP = 640 * MiB;
constexpr size_t WS_MOD = 645 * MiB;
constexpr size_t WS_SEGL = 646 * MiB;
constexpr size_t WS_SEGD = 662 * MiB;
constexpr size_t WS_BAR = 663 * MiB;
constexpr size_t WS_PART = 664 * MiB;
constexpr size_t WS_END = 696 * MiB;

__device__ __forceinline__ float bf2f(unsigned short b) { return __uint_as_float((unsigned)b << 16); }
__device__ __forceinline__ unsigned cvt_pk_bf16(float lo, float hi) { unsigned r; asm volatile("v_cvt_pk_bf16_f32 %0, %1, %2" : "=v"(r) : "v"(lo), "v"(hi)); return r; }
__device__ __forceinline__ unsigned short f2bf(float f) { return (unsigned short)(cvt_pk_bf16(f, 0.f) & 0xffffu); }
__device__ __forceinline__ void unpack8(const u32x4 r, float (&f)[8]) {
    f[0] = __uint_as_float(r.x << 16); f[1] = __uint_as_float(r.x & 0xffff0000u);
    f[2] = __uint_as_float(r.y << 16); f[3] = __uint_as_float(r.y & 0xffff0000u);
    f[4] = __uint_as_float(r.z << 16); f[5] = __uint_as_float(r.z & 0xffff0000u);
    f[6] = __uint_as_float(r.w << 16); f[7] = __uint_as_float(r.w & 0xffff0000u);
}
__device__ __forceinline__ f32x4 ld4_bf16(const bf16_t* p) { const u32x2 w = *(const u32x2*)p; return (f32x4){__uint_as_float(w.x << 16), __uint_as_float(w.x & 0xffff0000u), __uint_as_float(w.y << 16), __uint_as_float(w.y & 0xffff0000u)}; }
__device__ __forceinline__ float wave_sum(float v) {
#pragma unroll
    for (int o = 1; o < 64; o <<= 1) v += __shfl_xor(v, o);
    return v;
}
__device__ __forceinline__ float sigmoidf_fast(float x) { return __builtin_amdgcn_rcpf(1.0f + __expf(-x)); }
#define LDS_WAIT() asm volatile("s_waitcnt lgkmcnt(0)" ::: "memory")
#define LBAR() do { asm volatile("s_waitcnt lgkmcnt(0)" ::: "memory"); __builtin_amdgcn_s_barrier(); asm volatile("" ::: "memory"); } while (0)

namespace pg8 {
constexpr int BM = 256, BK = 64, HALF = 128, HTB = HALF * BK * 2, STAGE_BYTES = 8 * HTB, NXCD = 8, WGM = 8;
__device__ __forceinline__ int lds_byte(int r, int c) { const int st = (r >> 4) * 2 + (c >> 5), rr = r & 15, cc = c & 31, ob = rr * 64 + cc * 2; return st * 1024 + (ob ^ (((ob >> 9) & 1) << 5)); }
__device__ __forceinline__ void stage_rc(int b, int& R, int& C) { const int st = b / 1024, sb = b % 1024, swz = sb ^ (((sb >> 9) & 1) << 5); R = (st >> 1) * 16 + swz / 64; C = (st & 1) * 32 + (swz % 64) / 2; }
__device__ __forceinline__ int perm32(int rho) { const int n = rho >> 4, i = rho & 15; return 8 * (i >> 2) + 4 * n + (i & 3); }
struct Unit { int pm, pn, kt0, nkt, mode, slot; };
struct Gemm { const bf16_t* A; const bf16_t* Bt; int M, N, K; float* part; unsigned* flags; };
__device__ __forceinline__ void tile_of(int L, int nM, int nN, int nwg, int& pm, int& pn) {
    int wgid = L; { const int q = nwg / NXCD, r = nwg % NXCD, xcd = wgid % NXCD, off = wgid / NXCD; wgid = (xcd < r ? xcd * (q + 1) : r * (q + 1) + (xcd - r) * q) + off; }
    const int nig = WGM * nN, gid = wgid / nig, fm = gid * WGM, gsz = (nM - fm) < WGM ? (nM - fm) : WGM;
    pm = fm + ((wgid % nig) % gsz); pn = (wgid % nig) / gsz;
}
struct StaticOrder {
    int nM, nN, nwg, G, c, nt;
    __device__ void init(int M, int N, int K, int G_, int c_) { nM = M / BM; nN = N / BM; nwg = nM * nN; G = G_; c = c_; nt = K / BK; }
    __device__ bool next(int i, Unit& u) const {
        const long L = (long)i * G + c; if (L >= nwg) return false;
        tile_of((int)L, nM, nN, nwg, u.pm, u.pn); u.kt0 = 0; u.nkt = nt; u.mode = 0; u.slot = 0; return true;
    }
};
struct SplitOrder {
    int nM, nN, nwg, G, c, nt; bool split;
    __device__ void init(int M, int N, int K, int G_, int c_) { nM = M / BM; nN = N / BM; nwg = nM * nN; G = G_; c = c_; nt = K / BK; split = (2 * nwg == 3 * G) && (nt % 4 == 0) && (G % 16 == 0) && (nwg % 8 == 0); }
    __device__ bool next(int i, Unit& u) const {
        const int x = c & 7, j = c >> 3, q = j >> 1, r = j & 1;
        const bool half = (r == 0) ? (i == 0) : (i == 1);
        const int tau = 3 * q + (half ? 1 : (r == 0 ? 0 : 2));
        const int wg_split = x * (nwg >> 3) + tau;
        const int Ls = i * G + c; int ws = Ls < nwg ? Ls : 0; { const int qq = nwg / NXCD, rr = nwg % NXCD, xcd = ws % NXCD, off = ws / NXCD; ws = (xcd < rr ? xcd * (qq + 1) : rr * (qq + 1) + (xcd - rr) * qq) + off; }
        const int wgid = split ? wg_split : ws;
        const bool ok = split ? (i < 2) : (Ls < nwg);
        u.kt0 = (split && half && r == 1) ? (nt >> 1) : 0; u.nkt = (split && half) ? (nt >> 1) : nt; u.mode = (split && half) ? (r == 0 ? 1 : 2) : 0; u.slot = x * (G >> 4) + q;
        const int nig = WGM * nN, gid = wgid / nig, fm = gid * WGM, gsz = (nM - fm) < WGM ? (nM - fm) : WGM;
        u.pm = fm + ((wgid % nig) % gsz); u.pn = (wgid % nig) / gsz; return ok;
    }
};

template <int ACT  > struct EpiBf16 {
    static constexpr bool PERM = true;
    bf16_t* O; int ldc;
    __device__ __forceinline__ void operator()(const f32x4 (&acc)[2][2][4][2], const Unit& u, int wr, int wc, int fr, int fq) const {
        const int row0 = u.pm * BM + wr * 64 + fr; const int col0 = u.pn * BM + wc * 32 + 8 * fq;
        if (ACT == 0 && u.pn >= 24) {
            const int colq = 6144 + (u.pn - 24) * HALF + wc * 32 + 8 * fq;
#pragma unroll
            for (int ai = 0; ai < 2; ++ai)
#pragma unroll
                for (int m = 0; m < 4; ++m) { const f32x4 v0 = acc[ai][0][m][0] * acc[ai][1][m][0], v1 = acc[ai][0][m][1] * acc[ai][1][m][1];
                    u32x4 w; w.x = cvt_pk_bf16(v0[0], v0[1]); w.y = cvt_pk_bf16(v0[2], v0[3]); w.z = cvt_pk_bf16(v1[0], v1[1]); w.w = cvt_pk_bf16(v1[2], v1[3]);
                    *(u32x4*)(O + (size_t)(row0 + ai * HALF + m * 16) * ldc + colq) = w; }
            return;
        }
#pragma unroll
        for (int ai = 0; ai < 2; ++ai)
#pragma unroll
            for (int m = 0; m < 4; ++m) { bf16_t* rowp = O + (size_t)(row0 + ai * HALF + m * 16) * ldc + col0;
#pragma unroll
                for (int bj = 0; bj < 2; ++bj) { f32x4 v0 = acc[ai][bj][m][0], v1 = acc[ai][bj][m][1];
                    if (ACT == 0) { if (u.pn < 4 || (u.pn >= 16 && u.pn < 20)) {
#pragma unroll
                        for (int j = 0; j < 4; ++j) { v0[j] = v0[j] * __builtin_amdgcn_rcpf(1.0f + __builtin_amdgcn_exp2f(v0[j] * -1.44269504f)); v1[j] = v1[j] * __builtin_amdgcn_rcpf(1.0f + __builtin_amdgcn_exp2f(v1[j] * -1.44269504f)); } } }
                    if (ACT == 1) {
#pragma unroll
                        for (int j = 0; j < 4; ++j) { const float a = fmaxf(v0[j], 0.f), b = fmaxf(v1[j], 0.f); v0[j] = a * a; v1[j] = b * b; } }
                    u32x4 w; w.x = cvt_pk_bf16(v0[0], v0[1]); w.y = cvt_pk_bf16(v0[2], v0[3]); w.z = cvt_pk_bf16(v1[0], v1[1]); w.w = cvt_pk_bf16(v1[2], v1[3]);
                    *(u32x4*)(rowp + bj * HALF) = w; } }
    }
};
struct EpiRes {
    static constexpr bool PERM = true;
    const float* xp; const float* xs; const bf16_t* xin; bf16_t* xout; const float* mod; int gate_off; int layer0;
    __device__ __forceinline__ void operator()(const f32x4 (&acc)[2][2][4][2], const Unit& u, int wr, int wc, int fr, int fq) const {
        const int grp = u.pm < 16 ? 0 : (u.pm < 32 ? 1 : 2);
        const float* gate = mod + grp * MODW + gate_off;
        const float* base = u.pm < 16 ? xp + (size_t)u.pm * BM * DM : xs + (size_t)(u.pm - 16) * BM * DM;
        const bf16_t* baseb = xin + (size_t)u.pm * BM * DM;
        bf16_t* out = xout + (size_t)u.pm * BM * DM;
        const int row0 = wr * 64 + fr, col0 = u.pn * BM + wc * 32 + 8 * fq;
        f32x4 gv[2][2];
#pragma unroll
        for (int bj = 0; bj < 2; ++bj)
#pragma unroll
            for (int n = 0; n < 2; ++n) gv[bj][n] = *(const f32x4*)(gate + col0 + bj * HALF + 4 * n);
#pragma unroll
        for (int ai = 0; ai < 2; ++ai)
#pragma unroll
            for (int m = 0; m < 4; ++m) { const size_t off = (size_t)(row0 + ai * HALF + m * 16) * DM + col0;
#pragma unroll
                for (int bj = 0; bj < 2; ++bj) {
                    f32x4 b0, b1;
                    if (layer0) { b0 = *(const f32x4*)(base + off + bj * HALF); b1 = *(const f32x4*)(base + off + bj * HALF + 4); }
                    else { float t8[8]; unpack8(*(const u32x4*)(baseb + off + bj * HALF), t8); b0 = (f32x4){t8[0], t8[1], t8[2], t8[3]}; b1 = (f32x4){t8[4], t8[5], t8[6], t8[7]}; }
                    const f32x4 y0 = b0 + gv[bj][0] * acc[ai][bj][m][0], y1 = b1 + gv[bj][1] * acc[ai][bj][m][1];
                    *(u32x4*)(out + off + bj * HALF) = (u32x4){cvt_pk_bf16(y0.x, y0.y), cvt_pk_bf16(y0.z, y0.w), cvt_pk_bf16(y1.x, y1.y), cvt_pk_bf16(y1.z, y1.w)}; }
                asm volatile("" ::: "memory"); }
    }
};

template <class Epi, class Sched, bool SPLIT>
__device__ __forceinline__ void gemm_phase(LAS unsigned char* lds, const Gemm g, const Sched& S, const Epi& E, const int tid) {
    const int wid = __builtin_amdgcn_readfirstlane(tid >> 6), lane = tid & 63, wr = wid >> 2, wc = wid & 3, fr = lane & 15, fq = lane >> 4;
    const int K = g.K;
    unsigned voffA[2], voffB[2];
#pragma unroll
    for (int i = 0; i < 2; ++i) { int R, C; stage_rc(tid * 16 + i * 8192, R, C); const int Rb = Epi::PERM ? ((R & ~31) + perm32(R & 31)) : R;
        voffA[i] = (unsigned)(R * K + C) * 2u; voffB[i] = (unsigned)(Rb * K + C) * 2u; }
    const size_t kstep = (size_t)(BK * 2);
    const size_t hstep = (size_t)HALF * K * 2;
    const size_t tstep = 2 * hstep;
    const unsigned ldsw = (unsigned)wid * 1024u;
    const int aoff = lds_byte(wr * 64 + fr, fq * 8), boff = lds_byte(wc * 32 + fr, fq * 8);
#define PG8_SA(b, h) (((b) * 2 + (h)) * HTB)
#define PG8_SB(b, h) ((4 + (b) * 2 + (h)) * HTB)
#define PG8_STAGE(bufoff, gbase, voff) do { _Pragma("unroll") for (int _i = 0; _i < 2; ++_i) \
        __builtin_amdgcn_global_load_lds((const unsigned*)((const char*)(gbase) + (voff)[_i]), (LAS unsigned*)(lds + (bufoff) + ldsw + _i * 8192), 16, 0, 0); } while (0)
#define PG8_LDA(dst, b, h) do { _Pragma("unroll") for (int m = 0; m < 4; ++m) _Pragma("unroll") for (int k = 0; k < 2; ++k) dst[m][k] = *(const LAS bf16x8*)(lds + PG8_SA(b, h) + aoff + m * 2048 + k * 1024); } while (0)
#define PG8_LDB(dst, b, h) do { _Pragma("unroll") for (int n = 0; n < 2; ++n) _Pragma("unroll") for (int k = 0; k < 2; ++k) dst[n][k] = *(const LAS bf16x8*)(lds + PG8_SB(b, h) + boff + n * 2048 + k * 1024); } while (0)
#define PG8_MMA(ai, bj, At, Bt) do { __builtin_amdgcn_s_setprio(1); _Pragma("unroll") for (int m = 0; m < 4; ++m) _Pragma("unroll") for (int n = 0; n < 2; ++n) _Pragma("unroll") for (int k = 0; k < 2; ++k) \
        acc[ai][bj][m][n] = __builtin_amdgcn_mfma_f32_16x16x32_bf16(Bt[n][k], At[m][k], acc[ai][bj][m][n], 0, 0, 0); __builtin_amdgcn_s_setprio(0); } while (0)
#define PG8_WAIT_V(n) asm volatile("s_waitcnt vmcnt(" #n ")" ::: "memory")
#define PG8_WAIT_L(n) asm volatile("s_waitcnt lgkmcnt(" #n ")" ::: "memory")
#define PG8_BAR __builtin_amdgcn_s_barrier()
#define PG8_SCHED __builtin_amdgcn_sched_barrier(0)
    Unit cur, nxt; int ui = 0;
    if (!S.next(0, cur)) return;
    f32x4 acc[2][2][4][2];
#pragma unroll
    for (int a = 0; a < 2; ++a)
#pragma unroll
        for (int b = 0; b < 2; ++b)
#pragma unroll
            for (int m = 0; m < 4; ++m)
#pragma unroll
                for (int n = 0; n < 2; ++n) acc[a][b][m][n] = (f32x4){0.f, 0.f, 0.f, 0.f};
    bf16x8 At[4][2], B0[2][2], B1[2][2];
    const char* cA = (const char*)g.A + (size_t)cur.pm * tstep + (size_t)cur.kt0 * kstep; const char* cB = (const char*)g.Bt + (size_t)cur.pn * tstep + (size_t)cur.kt0 * kstep;
    PG8_STAGE(PG8_SB(0, 0), cB, voffB); PG8_STAGE(PG8_SA(0, 0), cA, voffA); PG8_STAGE(PG8_SB(0, 1), cB + hstep, voffB); PG8_STAGE(PG8_SA(0, 1), cA + hstep, voffA);
    if (wr == 1) PG8_BAR;
    PG8_WAIT_V(4); PG8_BAR;
    PG8_STAGE(PG8_SB(1, 0), cB + kstep, voffB); PG8_STAGE(PG8_SA(1, 0), cA + kstep, voffA); PG8_STAGE(PG8_SB(1, 1), cB + hstep + kstep, voffB);
    PG8_WAIT_V(6); PG8_BAR;
    for (;;) {
        const bool has_next = S.next(ui + 1, nxt);
        const char* nA = has_next ? (const char*)g.A + (size_t)nxt.pm * tstep + (size_t)nxt.kt0 * kstep : cA; const char* nB = has_next ? (const char*)g.Bt + (size_t)nxt.pn * tstep + (size_t)nxt.kt0 * kstep : cB;
        const int nt = cur.nkt;
        for (int t = 0; t < nt; t += 2) {
            const bool last = (t == nt - 2);
            const char* a1 = cA + (size_t)(t + 1) * kstep;
            const char* a2 = last ? nA : cA + (size_t)(t + 2) * kstep; const char* b2 = last ? nB : cB + (size_t)(t + 2) * kstep;
            const char* a3 = a2 + kstep; const char* b3 = b2 + kstep;
            PG8_LDB(B0, 0, 0); PG8_SCHED; PG8_LDA(At, 0, 0); PG8_STAGE(PG8_SA(1, 1), a1 + hstep, voffA);
            PG8_WAIT_L(8); PG8_BAR; PG8_WAIT_L(0); PG8_MMA(0, 0, At, B0); PG8_BAR; PG8_SCHED;
            PG8_LDB(B1, 0, 1); PG8_STAGE(PG8_SB(0, 0), b2, voffB);
            PG8_BAR; PG8_WAIT_L(0); PG8_MMA(0, 1, At, B1); PG8_BAR;
            PG8_LDA(At, 0, 1); PG8_STAGE(PG8_SA(0, 0), a2, voffA);
            PG8_BAR; PG8_WAIT_L(0); PG8_MMA(1, 0, At, B0); PG8_BAR; PG8_SCHED;
            PG8_STAGE(PG8_SB(0, 1), b2 + hstep, voffB);
            PG8_WAIT_V(6); PG8_BAR; PG8_MMA(1, 1, At, B1); PG8_BAR;
            PG8_LDB(B0, 1, 0); PG8_SCHED; PG8_LDA(At, 1, 0); PG8_STAGE(PG8_SA(0, 1), a2 + hstep, voffA);
            PG8_WAIT_L(8); PG8_BAR; PG8_WAIT_L(0); PG8_MMA(0, 0, At, B0); PG8_BAR; PG8_SCHED;
            PG8_LDB(B1, 1, 1); PG8_STAGE(PG8_SB(1, 0), b3, voffB);
            PG8_BAR; PG8_WAIT_L(0); PG8_MMA(0, 1, At, B1); PG8_BAR;
            PG8_LDA(At, 1, 1); PG8_STAGE(PG8_SA(1, 0), a3, voffA);
            PG8_BAR; PG8_WAIT_L(0); PG8_MMA(1, 0, At, B0); PG8_BAR; PG8_SCHED;
            PG8_STAGE(PG8_SB(1, 1), b3 + hstep, voffB);
            PG8_WAIT_V(6); PG8_BAR; PG8_MMA(1, 1, At, B1); PG8_BAR;
        }
        if (SPLIT && cur.mode != 0) {
            const bool wr_part = (cur.mode == 1);
            if (!wr_part) {
                unsigned sp_ = 0;
                while ((unsigned)__builtin_amdgcn_readfirstlane(__hip_atomic_load(g.flags + cur.slot * 16, __ATOMIC_RELAXED, __HIP_MEMORY_SCOPE_AGENT)) < 8u) { __builtin_amdgcn_s_sleep(2); if (++sp_ > (1u << 24)) break; }
                __builtin_amdgcn_fence(__ATOMIC_ACQUIRE, "agent");
                asm volatile("s_waitcnt vmcnt(0)" ::: "memory");
            }
            float* sp = g.part + (size_t)cur.slot * 65536 + tid * 4;
#pragma unroll
            for (int a = 0; a < 2; ++a)
#pragma unroll
                for (int b = 0; b < 2; ++b)
#pragma unroll
                    for (int m = 0; m < 4; ++m) {
#pragma unroll
                        for (int n = 0; n < 2; ++n) {
                            if (wr_part) *(f32x4*)sp = acc[a][b][m][n]; else acc[a][b][m][n] += *(const f32x4*)sp;
                            sp += 2048; asm volatile("" : "+v"(sp)); }
                        asm volatile("" ::: "memory"); }
            if (wr_part) {
                asm volatile("s_waitcnt vmcnt(0)" ::: "memory");
                __builtin_amdgcn_fence(__ATOMIC_RELEASE, "agent");
                asm volatile("s_waitcnt vmcnt(0)" ::: "memory");
                if (lane == 0) __hip_atomic_fetch_add(g.flags + cur.slot * 16, 1u, __ATOMIC_RELAXED, __HIP_MEMORY_SCOPE_AGENT);
            }
        }
        if (!(SPLIT && cur.mode == 1)) E(acc, cur, wr, wc, fr, fq);
        if (!has_next) break;
#pragma unroll
        for (int a = 0; a < 2; ++a)
#pragma unroll
            for (int b = 0; b < 2; ++b)
#pragma unroll
                for (int m = 0; m < 4; ++m)
#pragma unroll
                    for (int n = 0; n < 2; ++n) acc[a][b][m][n] = (f32x4){0.f, 0.f, 0.f, 0.f};
        cur = nxt; cA = nA; cB = nB; ++ui;
    }
    PG8_WAIT_V(0);
    if (wr == 0) PG8_BAR;
    PG8_BAR;
#undef PG8_SA
#undef PG8_SB
#undef PG8_STAGE
#undef PG8_LDA
#undef PG8_LDB
#undef PG8_MMA
#undef PG8_WAIT_V
#undef PG8_WAIT_L
#undef PG8_BAR
#undef PG8_SCHED
}
}

struct Args { const float* in[17]; float* out; unsigned char* ws; int ph_lo, ph_hi; };
typedef const __attribute__((address_space(4))) Args CArgs;
enum { I_XP = 0, I_XS, I_STATE, I_C, I_CCTX, I_N1G, I_N2G, I_WADA, I_BADA, I_WIN, I_LB, I_HGG, I_CONVW, I_WOUT, I_WM1, I_WM2, I_FING };

template <bool CUPAIR> __device__ __forceinline__ void p0_transpose_item(const float* __restrict__ W, int K, int N, bf16_t* __restrict__ WT, LAS float* scr, int item, int lane) {
    const int nblk = N / 32, kb = item / nblk, nb = item % nblk, k0 = 64 * kb, n0 = 32 * nb;
    int n0d = n0;
    if (CUPAIR && n0 >= 6144) { const int isu = n0 >= 7168 ? 1 : 0, ch0 = n0 - (isu ? 7168 : 6144); n0d = 6144 + 256 * (ch0 >> 7) + 128 * isu + (ch0 & 127); }
    float tmp[32];
#pragma unroll
    for (int i = 0; i < 32; ++i) { const int kk = 2 * i + (lane >> 5); tmp[i] = __builtin_nontemporal_load(&W[(size_t)(k0 + kk) * N + n0 + (lane & 31)]);   }
#pragma unroll
    for (int i = 0; i < 32; ++i) { const int kk = 2 * i + (lane >> 5); scr[kk * 33 + (lane & 31)] = tmp[i]; }
    LDS_WAIT(); asm volatile("" ::: "memory");
    const int c = lane & 7;
#pragma unroll
    for (int j = 0; j < 4; ++j) { const int n = (lane >> 3) + 8 * j; const LAS float* s = scr + (8 * c) * 33 + n;
        u32x4 o; o.x = cvt_pk_bf16(s[0 * 33], s[1 * 33]); o.y = cvt_pk_bf16(s[2 * 33], s[3 * 33]); o.z = cvt_pk_bf16(s[4 * 33], s[5 * 33]); o.w = cvt_pk_bf16(s[6 * 33], s[7 * 33]);
        *(u32x4*)(WT + (size_t)(n0d + n) * K + k0 + 8 * c) = o; }
    LDS_WAIT(); asm volatile("" ::: "memory");
}
constexpr int TI_IN = (DM / 64) * (INC / 32), TI_OUT = (DM / 64) * (DM / 32), TI_M1 = (DM / 64) * (DFF / 32), TI_M2 = (DFF / 64) * (DM / 32), TI_L = TI_IN + TI_OUT + TI_M1 + TI_M2;
__device__ __forceinline__ void transpose_dispatch(CArgs& a, int l, int r, LAS float* scr, int lane) {
    if (r < TI_IN) { p0_transpose_item<true>(a.in[I_WIN] + (size_t)l * DM * INC, DM, INC, (bf16_t*)(a.ws + WS_WIN) + (size_t)l * DM * INC, scr, r, lane); return; } r -= TI_IN;
    if (r < TI_OUT) { p0_transpose_item<false>(a.in[I_WOUT] + (size_t)l * DM * DM, DM, DM, (bf16_t*)(a.ws + WS_WOUT) + (size_t)l * DM * DM, scr, r, lane); return; } r -= TI_OUT;
    if (r < TI_M1) { p0_transpose_item<false>(a.in[I_WM1] + (size_t)l * DM * DFF, DM, DFF, (bf16_t*)(a.ws + WS_WM1) + (size_t)l * DM * DFF, scr, r, lane); return; } r -= TI_M1;
    p0_transpose_item<false>(a.in[I_WM2] + (size_t)l * DFF * DM, DFF, DM, (bf16_t*)(a.ws + WS_WM2) + (size_t)l * DFF * DM, scr, r, lane);
}
__device__ __forceinline__ void prologue_phase(CArgs& a, LAS unsigned char* lds, int tid, int wave, int lane, int G) {
    LAS float* sc = (LAS float*)lds;
    const float* w_ada = a.in[I_WADA]; float* modp = (float*)(a.ws + WS_MODP);
    for (int it = blockIdx.x; it < 2 * KS_ADA * 6; it += G) {
        const int l = it / (KS_ADA * 6), r = it % (KS_ADA * 6), ks = r / 6, cb = r % 6;
        __syncthreads();
        if (tid < 384) { const int g = tid >> 7, kk = tid & 127, k = 128 * ks + kk; const float cv = (g == 0) ? a.in[I_CCTX][k] : a.in[I_C][(g - 1) * DM + k]; sc[tid] = cv * sigmoidf_fast(cv); }
        __syncthreads();
        const int col = cb * 2048 + tid * 4;
        const float* wp = w_ada + ((size_t)l * DM + 128 * ks) * MODW + col;
        f32x4 a0 = {0.f, 0.f, 0.f, 0.f}, a1 = a0, a2 = a0;
#pragma unroll 8
        for (int kk = 0; kk < 128; ++kk) { const f32x4 w = __builtin_nontemporal_load((const f32x4*)(wp + (size_t)kk * MODW));   a0 += w * sc[kk]; a1 += w * sc[128 + kk]; a2 += w * sc[256 + kk]; }
        float* o = modp + (size_t)((l * KS_ADA + ks) * 3) * MODW + col;
        *(f32x4*)(o) = a0; *(f32x4*)(o + MODW) = a1; *(f32x4*)(o + 2 * MODW) = a2;
    }
    __syncthreads();
    LAS float* scr = (LAS float*)(lds + wave * 16384);
    constexpr int NIT = TI_IN + TI_OUT + TI_M1, NGEMV = 2 * KS_ADA * 6, XL = 7, XH = 15;
    const bool bal = (G == 256) && (NGEMV * 8 * XL + (256 - NGEMV) * 8 * XH == NIT);
    const bool light = (int)blockIdx.x < NGEMV;
    const int gw = blockIdx.x * 8 + wave;
    const int it0 = bal ? (light ? gw : NGEMV * 8 * XL + (gw - NGEMV * 8)) : gw;
    const int its = bal ? (light ? NGEMV * 8 : (256 - NGEMV) * 8) : G * 8;
    const int ite = bal ? (light ? NGEMV * 8 * XL : NIT) : NIT;
    for (int it = it0; it < ite; it += its) transpose_dispatch(a, 0, it, scr, lane);
}
__device__ __forceinline__ void side_transposes(CArgs& a, LAS unsigned char* lds, int lo, int hi, int wave, int lane, int G) {
    const int first = G >> 1; if ((int)blockIdx.x < first) return;
    LAS float* scr = (LAS float*)(lds + wave * 16384);
    for (int it = lo + ((int)blockIdx.x - first) * 8 + wave; it < hi; it += (G - first) * 8) transpose_dispatch(a, it / TI_L, it % TI_L, scr, lane);
}
__device__ __forceinline__ void finmod_phase(CArgs& a, int tid, int G) {
    const float* modp = (const float*)(a.ws + WS_MODP); float* mod = (float*)(a.ws + WS_MOD); const float* b_ada = a.in[I_BADA];
    for (int i = blockIdx.x * 512 + tid; i < 2 * 3 * MODW; i += G * 512) {
        const int l = i / (3 * MODW), r = i % (3 * MODW), g = r / MODW, c = r % MODW;
        float s = b_ada[l * MODW + c];
#pragma unroll
        for (int ks = 0; ks < KS_ADA; ++ks) s += modp[(size_t)((l * KS_ADA + ks) * 3 + g) * MODW + c];
        mod[i] = s;
    }
}

__device__ __forceinline__ const float* xrow_ptr(CArgs& a, int row) {
    return row < NCTX ? a.in[I_XP] + (size_t)row * DM : a.in[I_XS] + (size_t)(row - NCTX) * DM;
}
__device__ __forceinline__ void normmod_phase(CArgs& a, int layer0, const float* __restrict__ gvec, const float* __restrict__ mod, int sh_off, int sc_off, int wave, int lane, int G) {
    bf16_t* hb = (bf16_t*)(a.ws + WS_HB);
    const int gw = blockIdx.x * 8 + wave, NGW = G * 8;
    const int R = ((NTOK + NGW - 1) / NGW + 1) & ~1, rbeg = gw * R, rend = (rbeg + R < NTOK) ? rbeg + R : NTOK;
    int cur_grp = -1; f32x4 A[8], B[8];
    {
        for (int row = rbeg; row < rend; row += 2) {
            const int grp = row / NCTX;
            if (grp != cur_grp) { cur_grp = grp;
#pragma unroll
                for (int j = 0; j < 8; ++j) { const int col = (lane + 64 * j) * 4; const f32x4 g4 = *(const f32x4*)(gvec + col), s4 = *(const f32x4*)(mod + grp * MODW + sc_off + col);
                    A[j] = g4 * (s4 + 1.0f); B[j] = *(const f32x4*)(mod + grp * MODW + sh_off + col); } }
            const bool has2 = row + 1 < rend; const int row2 = has2 ? row + 1 : row;
            f32x4 v[8], w2[8]; float ss = 0.f, ss2 = 0.f;
            if (layer0) { const float* s0 = xrow_ptr(a, row); const float* s1 = xrow_ptr(a, row2);
#pragma unroll
                for (int j = 0; j < 8; ++j) { v[j] = *(const f32x4*)(s0 + (lane + 64 * j) * 4); w2[j] = *(const f32x4*)(s1 + (lane + 64 * j) * 4); } }
            else { const bf16_t* s0 = (const bf16_t*)(a.ws + WS_XRES) + (size_t)row * DM; const bf16_t* s1 = (const bf16_t*)(a.ws + WS_XRES) + (size_t)row2 * DM;
                u32x2 r0[8], r1[8];
#pragma unroll
                for (int j = 0; j < 8; ++j) { r0[j] = *(const u32x2*)(s0 + (lane + 64 * j) * 4); r1[j] = *(const u32x2*)(s1 + (lane + 64 * j) * 4); }
#pragma unroll
                for (int j = 0; j < 8; ++j) { v[j] = (f32x4){__uint_as_float(r0[j].x << 16), __uint_as_float(r0[j].x & 0xffff0000u), __uint_as_float(r0[j].y << 16), __uint_as_float(r0[j].y & 0xffff0000u)};
                                              w2[j] = (f32x4){__uint_as_float(r1[j].x << 16), __uint_as_float(r1[j].x & 0xffff0000u), __uint_as_float(r1[j].y << 16), __uint_as_float(r1[j].y & 0xffff0000u)}; } }
#pragma unroll
            for (int j = 0; j < 8; ++j) { ss += (v[j].x * v[j].x + v[j].y * v[j].y) + (v[j].z * v[j].z + v[j].w * v[j].w); ss2 += (w2[j].x * w2[j].x + w2[j].y * w2[j].y) + (w2[j].z * w2[j].z + w2[j].w * w2[j].w); }
            const float rstd = rsqrtf(wave_sum(ss) * (1.0f / DM) + EPS), rstd2 = rsqrtf(wave_sum(ss2) * (1.0f / DM) + EPS);
#pragma unroll
            for (int j = 0; j < 8; ++j) { const f32x4 y = v[j] * rstd * A[j] + B[j]; u32x2 w; w.x = cvt_pk_bf16(y.x, y.y); w.y = cvt_pk_bf16(y.z, y.w);
                *(u32x2*)(hb + (size_t)row * DM + (lane + 64 * j) * 4) = w; }
            if (has2) {
#pragma unroll
                for (int j = 0; j < 8; ++j) { const f32x4 y = w2[j] * rstd2 * A[j] + B[j]; u32x2 w; w.x = cvt_pk_bf16(y.x, y.y); w.y = cvt_pk_bf16(y.z, y.w);
                    *(u32x2*)(hb + (size_t)row2 * DM + (lane + 64 * j) * 4) = w; } }
        }
    }
}
__device__ __forceinline__ void final_phase(CArgs& a, int wave, int lane, int G) {
    const float* gvec = a.in[I_FING]; const bf16_t* xres = (const bf16_t*)(a.ws + WS_XRES);
    const int gw = blockIdx.x * 8 + wave, NGW = G * 8;
    f32x4 A[8];
#pragma unroll
    for (int j = 0; j < 8; ++j) A[j] = *(const f32x4*)(gvec + (lane + 64 * j) * 4);
    for (int row = gw; row < NTOK; row += 3 * NGW) {
        int rr[3]; bool ok[3];
#pragma unroll
        for (int k = 0; k < 3; ++k) { ok[k] = row + k * NGW < NTOK; rr[k] = ok[k] ? row + k * NGW : row; }
        u32x2 r[3][8];
#pragma unroll
        for (int k = 0; k < 3; ++k)
#pragma unroll
            for (int j = 0; j < 8; ++j) r[k][j] = *(const u32x2*)(xres + (size_t)rr[k] * DM + (lane + 64 * j) * 4);
#pragma unroll
        for (int k = 0; k < 3; ++k) {
            f32x4 v[8]; float ss = 0.f;
#pragma unroll
            for (int j = 0; j < 8; ++j) { v[j] = (f32x4){__uint_as_float(r[k][j].x << 16), __uint_as_float(r[k][j].x & 0xffff0000u), __uint_as_float(r[k][j].y << 16), __uint_as_float(r[k][j].y & 0xffff0000u)};
                ss += (v[j].x * v[j].x + v[j].y * v[j].y) + (v[j].z * v[j].z + v[j].w * v[j].w); }
            const float rstd = rsqrtf(wave_sum(ss) * (1.0f / DM) + EPS);
            if (ok[k]) {
#pragma unroll
                for (int j = 0; j < 8; ++j) *(f32x4*)(a.out + (size_t)rr[k] * DM + (lane + 64 * j) * 4) = v[j] * rstd * A[j]; }
        }
    }
}

constexpr int H_LF = 0, H_SQ = 16384, H_KK = 32768, H_QT = 49152, H_KT = 57856, H_KPT = 66560, H_VT = 76800  , H_PM = 97280, H_DD = 99840, H_OT = 100352  , H_LB = 117248  ;
constexpr int QS = 136;
constexpr int TS = 40;
constexpr int OTS = 132;
constexpr int VRS = 132;

__device__ __forceinline__ void hgrn_phase(CArgs& a, LAS unsigned char* lds, int l, int pass, int tid, int wave, int lane, int G) {
    const bf16_t* __restrict__ proj = (const bf16_t*)(a.ws + WS_PROJ);
    float* segL = (float*)(a.ws + WS_SEGL); float* segD = (float*)(a.ws + WS_SEGD);
    LAS float* LF = (LAS float*)(lds + H_LF); LAS bf16_t* SQR = (LAS bf16_t*)(lds + H_SQ);
    LAS bf16_t* QT = (LAS bf16_t*)(lds + H_QT); LAS bf16_t* KT = (LAS bf16_t*)(lds + H_KT); LAS bf16_t* KPT = (LAS bf16_t*)(lds + H_KPT);
    LAS bf16_t* PM = (LAS bf16_t*)(lds + H_PM); LAS float* DD = (LAS float*)(lds + H_DD); LAS float* OT = (LAS float*)(lds + H_OT); LAS float* LBV = (LAS float*)(lds + H_LB);
    const int n16 = lane & 15, kg = lane >> 4;
    const int tok = tid >> 4, c8 = tid & 15;
    const int dk = tid & 127, tq = wave >> 1;
    for (int i = tid; i < 32 * TS; i += 512) PM[i] = 0;
    const int nlat = (pass == 1) ? 32 * (NSEG - 1) : 32 * NSEG;
    const int nitems = (pass == 1) ? nlat : nlat + 256;
    for (int item = blockIdx.x; item < nitems; item += G) {
        int b, h, dir, T0, L, c0, nch, seg = 0, chain = 0; bool lat;
        if (item < nlat) { lat = true; const int ns = (pass == 1) ? (NSEG - 1) : NSEG; chain = item / ns; seg = item % ns; b = chain >> 4; h = (chain >> 1) & 7; dir = chain & 1; T0 = NCTX + b * 4096; L = 4096; c0 = seg * SEGCH; nch = SEGCH; }
        else { lat = false; const int j = item - nlat; b = j >> 4; h = (j >> 1) & 7; dir = j & 1; T0 = b * 256; L = 256; c0 = 0; nch = 8; }
        const bool want_out = (pass == 3);
        bf16_t* __restrict__ ofd = (bf16_t*)(a.ws + WS_OF) + (size_t)dir * NTOK * HW;
        u32x4 rq, rz, rv;
        { const int p = 32 * c0 + tok; const int row = T0 + (dir ? (L - 1 - p) : p); const bf16_t* bp = proj + (size_t)row * INC + h * 128 + c8 * 8;
          rq = *(const u32x4*)(bp); rv = *(const u32x4*)(bp + 1024); rz = *(const u32x4*)(bp + 2048 + dir * 1024); }
        __syncthreads();
        if (tid < 128) { float v = 0.f; if (l != 0) { const float l0 = a.in[I_LB][(0 * 2 + dir) * HW + h * 128 + tid], l1 = a.in[I_LB][(1 * 2 + dir) * HW + h * 128 + tid]; v = __builtin_amdgcn_rcpf(1.0f + __expf(l0 - l1)); } LBV[tid] = v; }
        f32x4 S[8];
#pragma unroll
        for (int t = 0; t < 8; ++t) S[t] = (f32x4){0.f, 0.f, 0.f, 0.f};
        if (lat && pass == 3) {
            const float* s0 = a.in[I_STATE] + ((size_t)(((b * 2 + l) * 2 + dir) * 8 + h)) * 16384 + wave * 16 + n16;
#pragma unroll
            for (int t = 0; t < 8; ++t)
#pragma unroll
                for (int j = 0; j < 4; ++j) S[t][j] = s0[(16 * t + 4 * kg + j) * 128];
            asm volatile("" ::: "memory");
#pragma unroll 2
            for (int sj = 0; sj < seg; ++sj) {
                const float* Lp = segL + (size_t)(chain * NSEG + sj) * 16384 + tid * 4; const float* Dp = segD + (size_t)(chain * NSEG + sj) * 128;
#pragma unroll
                for (int t = 0; t < 8; ++t) { const f32x4 d4 = *(const f32x4*)(Dp + 16 * t + 4 * kg); S[t] = S[t] * d4 + *(const f32x4*)(Lp + t * 2048); }
            }
        }
        float dprod = 1.f;
        __syncthreads();
#pragma unroll 1
        for (int ci = 0; ci < nch; ++ci) {
            const int c = c0 + ci;
            LAS bf16_t* VR = (LAS bf16_t*)(lds + H_VT + (ci & 1) * 10240);
            {
                float zf[8]; unpack8(rz, zf);
                float lf[8], lb[8];
                { const f32x4 b0 = *(const LAS f32x4*)(LBV + c8 * 8), b1 = *(const LAS f32x4*)(LBV + c8 * 8 + 4); lb[0] = b0.x; lb[1] = b0.y; lb[2] = b0.z; lb[3] = b0.w; lb[4] = b1.x; lb[5] = b1.y; lb[6] = b1.z; lb[7] = b1.w; }
#pragma unroll
                for (int i = 0; i < 8; ++i) {
                    const float z = fminf(fmaxf(zf[i], -60.f), 60.f);
                    const float sg = __builtin_amdgcn_rcpf(1.0f + __builtin_amdgcn_exp2f(z * -1.44269504f));
                    lf[i] = lb[i] + (1.0f - lb[i]) * sg;
                }
                const int o = tok * 128 + c8 * 8;
                *(LAS f32x4*)(LF + o) = (f32x4){lf[0], lf[1], lf[2], lf[3]}; *(LAS f32x4*)(LF + o + 4) = (f32x4){lf[4], lf[5], lf[6], lf[7]};
                if (want_out) *(LAS u32x4*)(SQR + o) = rq;
                *(LAS u32x2*)(VR + tok * VRS + c8 * 8) = (u32x2){rv.x, rv.y}; *(LAS u32x2*)(VR + tok * VRS + c8 * 8 + 4) = (u32x2){rv.z, rv.w};
            }
            if (ci + 1 < nch) { const int p = 32 * (c + 1) + tok; const int row = T0 + (dir ? (L - 1 - p) : p); const bf16_t* bp = proj + (size_t)row * INC + h * 128 + c8 * 8;
                rq = *(const u32x4*)(bp); rv = *(const u32x4*)(bp + 1024); rz = *(const u32x4*)(bp + 2048 + dir * 1024); }
            LBAR();
            if (want_out && ci > 0) {
                const int p = 32 * (c - 1) + tok; const int row = T0 + (dir ? (L - 1 - p) : p); bf16_t* op = ofd + (size_t)row * HW + h * 128 + c8 * 8;
                { const f32x4 x0 = *(const LAS f32x4*)(OT + tok * OTS + c8 * 8), x1 = *(const LAS f32x4*)(OT + tok * OTS + c8 * 8 + 4);
                  *(u32x4*)(op) = (u32x4){cvt_pk_bf16(x0.x, x0.y), cvt_pk_bf16(x0.z, x0.w), cvt_pk_bf16(x1.x, x1.y), cvt_pk_bf16(x1.z, x1.w)}; }
            }
            {
                float g4[4];
#pragma unroll
                for (int k = 0; k < 4; ++k) { float s = 1.f;
#pragma unroll
                    for (int j = 0; j < 8; ++j) s *= LF[(8 * k + j) * 128 + dk];
                    g4[k] = s; }
                const float dlast = (g4[0] * g4[1]) * (g4[2] * g4[3]);
                const float pre = (tq > 0 ? g4[0] : 1.f) * (tq > 1 ? g4[1] : 1.f) * (tq > 2 ? g4[2] : 1.f);
                const float post = (tq < 3 ? g4[3] : 1.f) * (tq < 2 ? g4[2] : 1.f) * (tq < 1 ? g4[1] : 1.f);
                float own[8], pfx[8], sfx[8];
#pragma unroll
                for (int j = 0; j < 8; ++j) own[j] = LF[(8 * tq + j) * 128 + dk];
                { float run = pre;
#pragma unroll
                  for (int j = 0; j < 8; ++j) { run *= own[j]; pfx[j] = run; }
                  run = post;
#pragma unroll
                  for (int j = 7; j >= 0; --j) { sfx[j] = run; run *= own[j]; } }
                float kp[8]; const float rdl = fminf(__builtin_amdgcn_rcpf(dlast), 1e34f);
#pragma unroll
                for (int j = 0; j < 8; ++j) { const int r = 8 * tq + j; const float k = 1.0f - own[j];
                    kp[j] = k * sfx[j];
                    if (want_out) { const float s = bf2f(SQR[r * 128 + dk]);
                        QT[r * QS + dk] = f2bf(s * pfx[j]); KT[r * QS + dk] = f2bf(kp[j] * rdl); } }
                u32x4 w; w.x = cvt_pk_bf16(kp[0], kp[1]); w.y = cvt_pk_bf16(kp[2], kp[3]); w.z = cvt_pk_bf16(kp[4], kp[5]); w.w = cvt_pk_bf16(kp[6], kp[7]);
                *(LAS u32x4*)(KPT + dk * TS + 8 * tq) = w;
                if (tq == 0) DD[dk] = dlast;
                dprod *= dlast;
            }
            LBAR();
            if (want_out) {
                if (wave < 3) {
                    const int mi = wave > 0 ? 1 : 0, ni = wave > 1 ? 1 : 0;
                    f32x4 pacc = {0.f, 0.f, 0.f, 0.f};
#pragma unroll
                    for (int ks = 0; ks < 4; ++ks) { const bf16x8 av = *(const LAS bf16x8*)(QT + (16 * mi + n16) * QS + 32 * ks + 8 * kg), bv = *(const LAS bf16x8*)(KT + (16 * ni + n16) * QS + 32 * ks + 8 * kg);
                        pacc = __builtin_amdgcn_mfma_f32_16x16x32_bf16(av, bv, pacc, 0, 0, 0); }
#pragma unroll
                    for (int j = 0; j < 4; ++j) { const int t = 16 * mi + 4 * kg + j, s = 16 * ni + n16; PM[t * TS + s] = f2bf(s <= t ? pacc[j] : 0.f); }
                }
                LBAR();
            }
            {
                bf16x8 vb;
                { const LAS bf16_t* vp = VR + (8 * kg) * VRS + 16 * wave + n16;
                  const u32x4 vw = {(unsigned)vp[0] | ((unsigned)vp[VRS] << 16), (unsigned)vp[2 * VRS] | ((unsigned)vp[3 * VRS] << 16), (unsigned)vp[4 * VRS] | ((unsigned)vp[5 * VRS] << 16), (unsigned)vp[6 * VRS] | ((unsigned)vp[7 * VRS] << 16)};
                  vb = __builtin_bit_cast(bf16x8, vw); }
                if (want_out) {
                    f32x4 o0 = {0.f, 0.f, 0.f, 0.f}, o1 = o0;
#pragma unroll
                    for (int ks = 0; ks < 4; ++ks) {
                        u32x4 sb; sb.x = cvt_pk_bf16(S[2 * ks][0], S[2 * ks][1]); sb.y = cvt_pk_bf16(S[2 * ks][2], S[2 * ks][3]); sb.z = cvt_pk_bf16(S[2 * ks + 1][0], S[2 * ks + 1][1]); sb.w = cvt_pk_bf16(S[2 * ks + 1][2], S[2 * ks + 1][3]);
                        const bf16x8 sbv = __builtin_bit_cast(bf16x8, sb);
                        u32x2 a0l = *(const LAS u32x2*)(QT + n16 * QS + 32 * ks + 4 * kg), a0h = *(const LAS u32x2*)(QT + n16 * QS + 32 * ks + 16 + 4 * kg);
                        u32x2 a1l = *(const LAS u32x2*)(QT + (16 + n16) * QS + 32 * ks + 4 * kg), a1h = *(const LAS u32x2*)(QT + (16 + n16) * QS + 32 * ks + 16 + 4 * kg);
                        const u32x4 A0 = {a0l.x, a0l.y, a0h.x, a0h.y}, A1 = {a1l.x, a1l.y, a1h.x, a1h.y};
                        o0 = __builtin_amdgcn_mfma_f32_16x16x32_bf16(__builtin_bit_cast(bf16x8, A0), sbv, o0, 0, 0, 0);
                        o1 = __builtin_amdgcn_mfma_f32_16x16x32_bf16(__builtin_bit_cast(bf16x8, A1), sbv, o1, 0, 0, 0);
                    }
                    const bf16x8 p0 = *(const LAS bf16x8*)(PM + n16 * TS + 8 * kg), p1 = *(const LAS bf16x8*)(PM + (16 + n16) * TS + 8 * kg);
                    o0 = __builtin_amdgcn_mfma_f32_16x16x32_bf16(p0, vb, o0, 0, 0, 0);
                    o1 = __builtin_amdgcn_mfma_f32_16x16x32_bf16(p1, vb, o1, 0, 0, 0);
#pragma unroll
                    for (int j = 0; j < 4; ++j) { OT[(4 * kg + j) * OTS + 16 * wave + n16] = o0[j]; OT[(16 + 4 * kg + j) * OTS + 16 * wave + n16] = o1[j]; }
                }
#pragma unroll
                for (int t = 0; t < 8; ++t) {
                    const f32x4 d4 = *(const LAS f32x4*)(DD + 16 * t + 4 * kg);
                    const bf16x8 ka = *(const LAS bf16x8*)(KPT + (16 * t + n16) * TS + 8 * kg);
                    S[t] = __builtin_amdgcn_mfma_f32_16x16x32_bf16(ka, vb, S[t] * d4, 0, 0, 0);
                }
            }
        }
        if (want_out) {
            __syncthreads();
            const int p = 32 * (c0 + nch - 1) + tok; const int row = T0 + (dir ? (L - 1 - p) : p); bf16_t* op = ofd + (size_t)row * HW + h * 128 + c8 * 8;
            { const f32x4 x0 = *(const LAS f32x4*)(OT + tok * OTS + c8 * 8), x1 = *(const LAS f32x4*)(OT + tok * OTS + c8 * 8 + 4);
              *(u32x4*)(op) = (u32x4){cvt_pk_bf16(x0.x, x0.y), cvt_pk_bf16(x0.z, x0.w), cvt_pk_bf16(x1.x, x1.y), cvt_pk_bf16(x1.z, x1.w)}; }
        }
        if (pass == 1) {
            float* Lp = segL + (size_t)(chain * NSEG + seg) * 16384 + tid * 4;
#pragma unroll
            for (int t = 0; t < 8; ++t) *(f32x4*)(Lp + t * 2048) = S[t];
            if (tq == 0) segD[(size_t)(chain * NSEG + seg) * 128 + dk] = dprod;
        } else if (!lat) {
            float* sp = a.out + (size_t)NTOK * DM + ((size_t)(((b * 2 + l) * 2 + dir) * 8 + h)) * 16384 + wave * 16 + n16;
#pragma unroll
            for (int t = 0; t < 8; ++t)
#pragma unroll
                for (int j = 0; j < 4; ++j) sp[(16 * t + 4 * kg + j) * 128] = S[t][j];
        }
    }
}

__device__ __forceinline__ void combine_phase(CArgs& a, int l, int wave, int lane, int G) {
    const bf16_t* __restrict__ proj = (const bf16_t*)(a.ws + WS_PROJ);
    const bf16_t* __restrict__ of = (const bf16_t*)(a.ws + WS_OF); const bf16_t* __restrict__ ob = of + (size_t)NTOK * HW;
    bf16_t* hb = (bf16_t*)(a.ws + WS_HB);
    const float* hgg = a.in[I_HGG] + l * HW + 16 * lane; const float* cw = a.in[I_CONVW] + l * 3 * HW + 16 * lane;
    const int gw = blockIdx.x * 8 + wave, NGW = G * 8;
    for (int t = gw; t < NTOK; t += NGW) {
        float o[16]; float ss = 0.f;
#pragma unroll
        for (int q = 0; q < 2; ++q) { float xf[8], xb[8]; unpack8(*(const u32x4*)(of + (size_t)t * HW + 16 * lane + 8 * q), xf); unpack8(*(const u32x4*)(ob + (size_t)t * HW + 16 * lane + 8 * q), xb);
#pragma unroll
            for (int i = 0; i < 8; ++i) { const float x = xf[i] + xb[i]; o[8 * q + i] = x; ss += x * x; } }
        ss += __shfl_xor(ss, 1); ss += __shfl_xor(ss, 2); ss += __shfl_xor(ss, 4);
        const float rstd = rsqrtf(ss * (1.0f / 128.0f) + EPS);
        const bf16_t* pr = proj + (size_t)t * INC + 16 * lane;
        float gf[16]; { float t8[8]; unpack8(*(const u32x4*)(pr + 4096), t8); for (int i = 0; i < 8; ++i) gf[i] = t8[i]; unpack8(*(const u32x4*)(pr + 4096 + 8), t8); for (int i = 0; i < 8; ++i) gf[8 + i] = t8[i]; }
        unsigned w[8];
#pragma unroll
        for (int i = 0; i < 8; ++i) { const float y0 = o[2 * i] * rstd * hgg[2 * i] * gf[2 * i], y1 = o[2 * i + 1] * rstd * hgg[2 * i + 1] * gf[2 * i + 1]; w[i] = cvt_pk_bf16(y0, y1); }
        *(u32x4*)(hb + (size_t)t * DM + 16 * lane) = (u32x4){w[0], w[1], w[2], w[3]}; *(u32x4*)(hb + (size_t)t * DM + 16 * lane + 8) = (u32x4){w[4], w[5], w[6], w[7]};
        int st; bool hp, hn;
        if (t < NCTX) { const int i = t & 255; st = 1; hp = i != 0; hn = i != 255; }
        else { const int i = (t - NCTX) & 4095; if ((l & 1) == 0) { const int cc = i & 63; st = 1; hp = cc != 0; hn = cc != 63; } else { st = 64; hp = i >= 64; hn = i < 4096 - 64; } }
        float uc[16], up[16], un[16], bb[16];
        { float x8[8];
#pragma unroll
          for (int hlf = 0; hlf < 2; ++hlf) {
            unpack8(*(const u32x4*)(pr + 6144 + 8 * hlf), x8);
#pragma unroll
            for (int i = 0; i < 8; ++i) uc[8 * hlf + i] = x8[i];
            if (hp) { unpack8(*(const u32x4*)(pr - (size_t)st * INC + 6144 + 8 * hlf), x8);
#pragma unroll
                for (int i = 0; i < 8; ++i) up[8 * hlf + i] = x8[i]; }
            else {
#pragma unroll
                for (int i = 0; i < 8; ++i) up[8 * hlf + i] = 0.f; }
            if (hn) { unpack8(*(const u32x4*)(pr + (size_t)st * INC + 6144 + 8 * hlf), x8);
#pragma unroll
                for (int i = 0; i < 8; ++i) un[8 * hlf + i] = x8[i]; }
            else {
#pragma unroll
                for (int i = 0; i < 8; ++i) un[8 * hlf + i] = 0.f; }
            unpack8(*(const u32x4*)(pr + 5120 + 8 * hlf), x8);
#pragma unroll
            for (int i = 0; i < 8; ++i) bb[8 * hlf + i] = x8[i];
          } }
#pragma unroll
        for (int i = 0; i < 8; ++i) {
            const float y0 = bb[2 * i] * (cw[2 * i] * up[2 * i] + cw[HW + 2 * i] * uc[2 * i] + cw[2 * HW + 2 * i] * un[2 * i]);
            const float y1 = bb[2 * i + 1] * (cw[2 * i + 1] * up[2 * i + 1] + cw[HW + 2 * i + 1] * uc[2 * i + 1] + cw[2 * HW + 2 * i + 1] * un[2 * i + 1]);
            w[i] = cvt_pk_bf16(y0, y1); }
        *(u32x4*)(hb + (size_t)t * DM + HW + 16 * lane) = (u32x4){w[0], w[1], w[2], w[3]}; *(u32x4*)(hb + (size_t)t * DM + HW + 16 * lane + 8) = (u32x4){w[4], w[5], w[6], w[7]};
    }
}

#define XB_TMO      128
#define XB_XCNT(j)  (256  + 64 * (j))
#define XB_XSUB(j)  (1280 + 64 * (j))
#define XB_XGEN(j)  (2304 + 64 * (j))
#define XB_TOP      3328
#define XB_TOPGEN   3392
#define XCD_BAR_WORDS 3456
#define SPLIT_FLAG_BASE 4096
#define CTL_WORDS (4096 + 4 * 128 * 16)
#define XB_SPIN_CAP (1u << 22)
__device__ __forceinline__ unsigned xb_ld(unsigned* p)              { return __hip_atomic_load(p, __ATOMIC_RELAXED, __HIP_MEMORY_SCOPE_AGENT); }
__device__ __forceinline__ unsigned xb_add(unsigned* p, unsigned v) { return __hip_atomic_fetch_add(p, v, __ATOMIC_RELAXED, __HIP_MEMORY_SCOPE_AGENT); }
__device__ __forceinline__ unsigned xb_xcc_id() { return (unsigned)__builtin_amdgcn_s_getreg((3 << 11) | 20) & 0xFu; }
#define XB_SPIN(cond, bar) do { unsigned _sp = 0; while (cond) { __builtin_amdgcn_s_sleep(1); \
    if ((++_sp & 255u) == 0u) { if (xb_ld(&(bar)[XB_TMO])) break; if (_sp > XB_SPIN_CAP) { atomicAdd(&(bar)[XB_TMO], 1u); break; } } } } while (0)
struct XcdBarrier { unsigned* bar; unsigned x; volatile LAS unsigned* st; };
__device__ __forceinline__ XcdBarrier xcd_barrier_post(unsigned* bar, volatile LAS unsigned* st) {
    XcdBarrier b; b.bar = bar; b.x = xb_xcc_id(); b.st = st;
    if (threadIdx.x == 0) (void)xb_add(&bar[XB_XCNT(b.x)], 1u);
    return b;
}
__device__ __forceinline__ void xcd_barrier_complete(unsigned* bar, unsigned x, unsigned& nloc, unsigned& nx) {
    const unsigned G = gridDim.x * gridDim.y * gridDim.z;
    unsigned sum, cnt, mine, sp = 0u;
    for (;;) {
        sum = 0u; cnt = 0u; mine = 0u;
#pragma unroll
        for (unsigned j = 0; j < 16; ++j) { const unsigned c = xb_ld(&bar[XB_XCNT(j)]); sum += c; cnt += (c > 0u) ? 1u : 0u; mine = (j == x) ? c : mine; }
        if (sum == G) break;
        __builtin_amdgcn_s_sleep(1);
        if ((++sp & 255u) == 0u) { if (xb_ld(&bar[XB_TMO])) break; if (sp > XB_SPIN_CAP) { atomicAdd(&bar[XB_TMO], 1u); break; } }
    }
    nloc = mine > 0u ? mine : 1u; nx = cnt > 0u ? cnt : 1u;
}
__device__ __forceinline__ void xcd_barrier(const XcdBarrier& b) {
    asm volatile("s_waitcnt vmcnt(0)" ::: "memory");
    __syncthreads();
    if (threadIdx.x == 0) {
        unsigned* bar = b.bar;
        __builtin_amdgcn_s_waitcnt(0);
        unsigned nloc = b.st[0], nx = b.st[1];
        if (nloc == 0u) { xcd_barrier_complete(bar, b.x, nloc, nx); b.st[0] = nloc; b.st[1] = nx; }
        const unsigned old = xb_add(&bar[XB_XSUB(b.x)], 1u);
        const unsigned gen = old / nloc;
        if (old + 1u == (gen + 1u) * nloc) {
            __builtin_amdgcn_fence(__ATOMIC_RELEASE, "agent");
            asm volatile("s_waitcnt vmcnt(0)" ::: "memory");
            const unsigned og = xb_add(&bar[XB_TOP], 1u);
            const unsigned tg = og / nx;
            if (og + 1u == (tg + 1u) * nx) xb_add(&bar[XB_TOPGEN], 1u);
            else XB_SPIN(xb_ld(&bar[XB_TOPGEN]) == tg, bar);
            __builtin_amdgcn_fence(__ATOMIC_ACQUIRE, "agent");
            xb_add(&bar[XB_XGEN(b.x)], 1u);
            asm volatile("s_waitcnt vmcnt(0)" ::: "memory");
        } else {
            XB_SPIN(xb_ld(&bar[XB_XGEN(b.x)]) == gen, bar);
            __builtin_amdgcn_fence(__ATOMIC_ACQUIRE, "agent");
            asm volatile("s_waitcnt vmcnt(0)" ::: "memory");
        }
    }
    __syncthreads();
}

__global__ void __launch_bounds__(512, 2) fwd_kernel(Args a) {
    extern __shared__ __attribute__((aligned(16))) unsigned char lds_raw[];
    LAS unsigned char* lds = (LAS unsigned char*)lds_raw;
    const int G = gridDim.x;
    cg::grid_group grid = cg::this_grid();
#define HB ((bf16_t*)(a.ws + WS_HB))
#define PROJ ((bf16_t*)(a.ws + WS_PROJ))
#define XRES ((bf16_t*)(a.ws + WS_XRES))
#define PH(p) (a.ph_lo <= (p) && (p) < a.ph_hi)
#define TIDS() CArgs* lap_ = (CArgs*)__builtin_amdgcn_kernarg_segment_ptr(); asm volatile("" : "+s"(lap_)); CArgs& a = *lap_; int tid = threadIdx.x; asm volatile("" : "+v"(tid)); const int lane = tid & 63, wave = __builtin_amdgcn_readfirstlane(tid >> 6); (void)lane; (void)wave
    volatile LAS unsigned* bst = (volatile LAS unsigned*)(lds + LDS_BYTES - 64);
    if (threadIdx.x == 0) { bst[0] = 0u; bst[1] = 0u; }
    unsigned* barw = (unsigned*)(a.ws + WS_BAR);
    const bool single = (a.ph_hi - a.ph_lo) > 1;
    __syncthreads();
    XcdBarrier xbar; xbar.bar = barw; xbar.x = 0; xbar.st = bst;
    if (single) xbar = xcd_barrier_post(barw, bst);
    if (a.ph_hi < 0) grid.sync();
#define SEAM(p) do { if ((p) + 1 < a.ph_hi) xcd_barrier(xbar); } while (0)
    if (PH(0)) { TIDS(); for (int rep = 0; rep < REP_PRO; ++rep) prologue_phase(a, lds, tid, wave, lane, G); SEAM(0); }
    if (PH(1)) { TIDS(); finmod_phase(a, tid, G); SEAM(1); }
#pragma unroll
    for (int l = 0; l < 2; ++l) {
        const int p0 = 2 + 9 * l;
#define mod ((const float*)(a.ws + WS_MOD) + (size_t)l * 3 * MODW)
        if (PH(p0 + 0)) { TIDS(); for (int rep = 0; rep < REP_MISC; ++rep) normmod_phase(a, l == 0, a.in[I_N1G] + l * DM, mod, 0 * DM, 1 * DM, wave, lane, G); SEAM(p0 + 0); }
        if (PH(p0 + 1)) { TIDS(); pg8::Gemm g{HB, (const bf16_t*)(a.ws + WS_WIN) + (size_t)l * DM * INC, NTOK, INC, DM, nullptr, nullptr}; pg8::StaticOrder S; S.init(NTOK, INC, DM, G, (int)blockIdx.x);
                  pg8::EpiBf16<0> E{PROJ, INC}; for (int rep = 0; rep < REP_GBIG; ++rep) pg8::gemm_phase<decltype(E), pg8::StaticOrder, false>(lds, g, S, E, tid); SEAM(p0 + 1); }
        if (PH(p0 + 2)) { TIDS(); if (NSEG > 1) for (int rep = 0; rep < REP_H1; ++rep) hgrn_phase(a, lds, l, 1, tid, wave, lane, G); SEAM(p0 + 2); }
        if (PH(p0 + 3)) { TIDS(); for (int rep = 0; rep < REP_HG; ++rep) hgrn_phase(a, lds, l, 3, tid, wave, lane, G); SEAM(p0 + 3); }
        if (PH(p0 + 4)) { TIDS(); for (int rep = 0; rep < REP_CB; ++rep) combine_phase(a, l, wave, lane, G); SEAM(p0 + 4); }
        if (PH(p0 + 5)) { TIDS(); pg8::Gemm g{HB, (const bf16_t*)(a.ws + WS_WOUT) + (size_t)l * DM * DM, NTOK, DM, DM, (float*)(a.ws + WS_PART), (unsigned*)(a.ws + WS_BAR) + SPLIT_FLAG_BASE + (l * 2 + 0) * 2048}; pg8::StaticOrder S; S.init(NTOK, DM, DM, G, (int)blockIdx.x);
                  pg8::EpiRes E{a.in[I_XP], a.in[I_XS], XRES, XRES, mod, 2 * DM, l == 0}; pg8::gemm_phase<pg8::EpiRes, pg8::StaticOrder, false>(lds, g, S, E, tid);
                  if (l == 0) side_transposes(a, lds, TI_IN + TI_OUT + TI_M1, TI_L, wave, lane, G); SEAM(p0 + 5); }
        if (PH(p0 + 6)) { TIDS(); for (int rep = 0; rep < REP_MISC; ++rep) normmod_phase(a, 0, a.in[I_N2G] + l * DM, mod, 3 * DM, 4 * DM, wave, lane, G); SEAM(p0 + 6); }
        if (PH(p0 + 7)) { TIDS(); pg8::Gemm g{HB, (const bf16_t*)(a.ws + WS_WM1) + (size_t)l * DM * DFF, NTOK, DFF, DM, nullptr, nullptr}; pg8::StaticOrder S; S.init(NTOK, DFF, DM, G, (int)blockIdx.x);
                  pg8::EpiBf16<1> E{PROJ, DFF}; for (int rep = 0; rep < REP_GBIG; ++rep) pg8::gemm_phase<decltype(E), pg8::StaticOrder, false>(lds, g, S, E, tid); SEAM(p0 + 7); }
        if (PH(p0 + 8)) { TIDS(); pg8::Gemm g{PROJ, (const bf16_t*)(a.ws + WS_WM2) + (size_t)l * DFF * DM, NTOK, DM, DFF, (float*)(a.ws + WS_PART), (unsigned*)(a.ws + WS_BAR) + SPLIT_FLAG_BASE + (l * 2 + 1) * 2048}; pg8::StaticOrder S; S.init(NTOK, DM, DFF, G, (int)blockIdx.x);
                  pg8::EpiRes E{a.in[I_XP], a.in[I_XS], XRES, XRES, mod, 5 * DM, 0}; pg8::gemm_phase<pg8::EpiRes, pg8::StaticOrder, false>(lds, g, S, E, tid);
                  if (l == 0) side_transposes(a, lds, TI_L, 2 * TI_L, wave, lane, G); SEAM(p0 + 8); }
    }
    if (PH(20)) { TIDS(); for (int rep = 0; rep < REP_MISC; ++rep) final_phase(a, wave, lane, G); }
}

extern "C" void kernel_launch(void* const* d_in, const int* in_sizes, int n_in, void* d_out, int out_size, void* d_ws, size_t ws_size, hipStream_t stream) {
    static int grid = 0;
    if (grid == 0) {
        if (n_in != 17 || ws_size < WS_END) { fprintf(stderr, "kernel_launch: expected 17 inputs and >= %zu bytes of workspace, got %d / %zu\n", (size_t)WS_END, n_in, ws_size); grid = -1; return; }
        int dev = 0, cus = 0, per_cu = 0;
        hipGetDevice(&dev); hipDeviceGetAttribute(&cus, hipDeviceAttributeMultiprocessorCount, dev);
        if (hipFuncSetAttribute((const void*)fwd_kernel, hipFuncAttributeMaxDynamicSharedMemorySize, LDS_BYTES) != hipSuccess) { fprintf(stderr, "kernel_launch: hipFuncSetAttribute failed\n"); grid = -1; return; }
        if (hipOccupancyMaxActiveBlocksPerMultiprocessor(&per_cu, (const void*)fwd_kernel, 512, LDS_BYTES) != hipSuccess || per_cu < 1) { fprintf(stderr, "kernel_launch: occupancy query gave %d\n", per_cu); per_cu = 1; }
        (void)hipGetLastError();
        grid = cus * per_cu;
        fprintf(stderr, "kernel_launch: grid %d (%d CUs x %d)\n", grid, cus, per_cu);
    }
    if (grid < 0) return;
    Args a{};
    for (int i = 0; i < 17; ++i) a.in[i] = (const float*)d_in[i];
    a.out = (float*)d_out; a.ws = (unsigned char*)d_ws;
#if MK_SINGLE
    a.ph_lo = 0; a.ph_hi = NPHASE;
    if (hipMemsetAsync((char*)d_ws + WS_BAR, 0, (size_t)CTL_WORDS * 4, stream) != hipSuccess) { fprintf(stderr, "kernel_launch: memset of the barrier words failed\n"); return; }
    void* args[] = {&a};
    hipError_t e = hipLaunchCooperativeKernel((const void*)fwd_kernel, dim3(grid), dim3(512), args, LDS_BYTES, stream);
    if (e != hipSuccess) fprintf(stderr, "cooperative launch failed: %s (grid %d)\n", hipGetErrorString(e), grid);
#else
    for (int ph = 0; ph < NPHASE; ++ph) {
        if (NSEG == 1 && (ph == 4 || ph == 13)) continue;
        a.ph_lo = ph; a.ph_hi = ph + 1;
        hipLaunchKernelGGL(fwd_kernel, dim3(grid), dim3(512), LDS_BYTES, stream, a);
    }
#endif
}
```

```cpp
#include <hip/hip_runtime.h>
#include <hip/hip_cooperative_groups.h>
#include <cstdio>
namespace cg = cooperative_groups;

#ifndef REP_GBIG
#define REP_GBIG 1
#endif
#ifndef REP_HG
#define REP_HG 1
#endif
#ifndef REP_MISC
#define REP_MISC 1
#endif
#ifndef REP_PRO
#define REP_PRO 1
#endif
#ifndef REP_CB
#define REP_CB 1
#endif
#ifndef REP_H1
#define REP_H1 1
#endif
#ifndef MK_SINGLE
#define MK_SINGLE 1
#endif

#define LAS __attribute__((address_space(3)))
typedef unsigned short bf16_t;
typedef short bf16x8 __attribute__((ext_vector_type(8)));
typedef short bf16x4 __attribute__((ext_vector_type(4)));
typedef float f32x4 __attribute__((ext_vector_type(4)));
typedef unsigned u32x4 __attribute__((ext_vector_type(4)));
typedef unsigned u32x2 __attribute__((ext_vector_type(2)));

constexpr int DM = 2048, NCTX = 4096, NTOK = 12288, HW = 1024, INC = 8192, DFF = 8192, MODW = 12288;
constexpr int NSEG = 8;
constexpr int SEGCH = 128 / NSEG;
constexpr float EPS = 1e-6f;
constexpr int KS_ADA = 16;
constexpr int NPHASE = 21;
constexpr int LDS_BYTES = 135168;

constexpr size_t MiB = 1u << 20;
constexpr size_t WS_WIN = 0;
constexpr size_t WS_WOUT = 64 * MiB;
constexpr size_t WS_WM1 = 80 * MiB;
constexpr size_t WS_WM2 = 144 * MiB;
constexpr size_t WS_XRES = 208 * MiB;
constexpr size_t WS_HB = 304 * MiB;
constexpr size_t WS_PROJ = 352 * MiB;
constexpr size_t WS_OF = 544 * MiB;
constexpr size_t WS_MODP = 640 * MiB;
constexpr size_t WS_MOD = 645 * MiB;
constexpr size_t WS_SEGL = 646 * MiB;
constexpr size_t WS_SEGD = 662 * MiB;
constexpr size_t WS_BAR = 663 * MiB;
constexpr size_t WS_PART = 664 * MiB;
constexpr size_t WS_END = 696 * MiB;

__device__ __forceinline__ float bf2f(unsigned short b) { return __uint_as_float((unsigned)b << 16); }
__device__ __forceinline__ unsigned cvt_pk_bf16(float lo, float hi) { unsigned r; asm volatile("v_cvt_pk_bf16_f32 %0, %1, %2" : "=v"(r) : "v"(lo), "v"(hi)); return r; }
__device__ __forceinline__ unsigned short f2bf(float f) { return (unsigned short)(cvt_pk_bf16(f, 0.f) & 0xffffu); }
__device__ __forceinline__ void unpack8(const u32x4 r, float (&f)[8]) {
    f[0] = __uint_as_float(r.x << 16); f[1] = __uint_as_float(r.x & 0xffff0000u);
    f[2] = __uint_as_float(r.y << 16); f[3] = __uint_as_float(r.y & 0xffff0000u);
    f[4] = __uint_as_float(r.z << 16); f[5] = __uint_as_float(r.z & 0xffff0000u);
    f[6] = __uint_as_float(r.w << 16); f[7] = __uint_as_float(r.w & 0xffff0000u);
}
__device__ __forceinline__ f32x4 ld4_bf16(const bf16_t* p) { const u32x2 w = *(const u32x2*)p; return (f32x4){__uint_as_float(w.x << 16), __uint_as_float(w.x & 0xffff0000u), __uint_as_float(w.y << 16), __uint_as_float(w.y & 0xffff0000u)}; }
__device__ __forceinline__ float wave_sum(float v) {
#pragma unroll
    for (int o = 1; o < 64; o <<= 1) v += __shfl_xor(v, o);
    return v;
}
__device__ __forceinline__ float sigmoidf_fast(float x) { return __builtin_amdgcn_rcpf(1.0f + __expf(-x)); }
#define LDS_WAIT() asm volatile("s_waitcnt lgkmcnt(0)" ::: "memory")
#define LBAR() do { asm volatile("s_waitcnt lgkmcnt(0)" ::: "memory"); __builtin_amdgcn_s_barrier(); asm volatile("" ::: "memory"); } while (0)

namespace pg8 {
constexpr int BM = 256, BK = 64, HALF = 128, HTB = HALF * BK * 2, STAGE_BYTES = 8 * HTB, NXCD = 8, WGM = 8;
__device__ __forceinline__ int lds_byte(int r, int c) { const int st = (r >> 4) * 2 + (c >> 5), rr = r & 15, cc = c & 31, ob = rr * 64 + cc * 2; return st * 1024 + (ob ^ (((ob >> 9) & 1) << 5)); }
__device__ __forceinline__ void stage_rc(int b, int& R, int& C) { const int st = b / 1024, sb = b % 1024, swz = sb ^ (((sb >> 9) & 1) << 5); R = (st >> 1) * 16 + swz / 64; C = (st & 1) * 32 + (swz % 64) / 2; }
__device__ __forceinline__ int perm32(int rho) { const int n = rho >> 4, i = rho & 15; return 8 * (i >> 2) + 4 * n + (i & 3); }
struct Unit { int pm, pn, kt0, nkt, mode, slot; };
struct Gemm { const bf16_t* A; const bf16_t* Bt; int M, N, K; float* part; unsigned* flags; };
__device__ __forceinline__ void tile_of(int L, int nM, int nN, int nwg, int& pm, int& pn) {
    int wgid = L; { const int q = nwg / NXCD, r = nwg % NXCD, xcd = wgid % NXCD, off = wgid / NXCD; wgid = (xcd < r ? xcd * (q + 1) : r * (q + 1) + (xcd - r) * q) + off; }
    const int nig = WGM * nN, gid = wgid / nig, fm = gid * WGM, gsz = (nM - fm) < WGM ? (nM - fm) : WGM;
    pm = fm + ((wgid % nig) % gsz); pn = (wgid % nig) / gsz;
}
struct StaticOrder {
    int nM, nN, nwg, G, c, nt;
    __device__ void init(int M, int N, int K, int G_, int c_) { nM = M / BM; nN = N / BM; nwg = nM * nN; G = G_; c = c_; nt = K / BK; }
    __device__ bool next(int i, Unit& u) const {
        const long L = (long)i * G + c; if (L >= nwg) return false;
        tile_of((int)L, nM, nN, nwg, u.pm, u.pn); u.kt0 = 0; u.nkt = nt; u.mode = 0; u.slot = 0; return true;
    }
};
struct SplitOrder {
    int nM, nN, nwg, G, c, nt; bool split;
    __device__ void init(int M, int N, int K, int G_, int c_) { nM = M / BM; nN = N / BM; nwg = nM * nN; G = G_; c = c_; nt = K / BK; split = (2 * nwg == 3 * G) && (nt % 4 == 0) && (G % 16 == 0) && (nwg % 8 == 0); }
    __device__ bool next(int i, Unit& u) const {
        const int x = c & 7, j = c >> 3, q = j >> 1, r = j & 1;
        const bool half = (r == 0) ? (i == 0) : (i == 1);
        const int tau = 3 * q + (half ? 1 : (r == 0 ? 0 : 2));
        const int wg_split = x * (nwg >> 3) + tau;
        const int Ls = i * G + c; int ws = Ls < nwg ? Ls : 0; { const int qq = nwg / NXCD, rr = nwg % NXCD, xcd = ws % NXCD, off = ws / NXCD; ws = (xcd < rr ? xcd * (qq + 1) : rr * (qq + 1) + (xcd - rr) * qq) + off; }
        const int wgid = split ? wg_split : ws;
        const bool ok = split ? (i < 2) : (Ls < nwg);
        u.kt0 = (split && half && r == 1) ? (nt >> 1) : 0; u.nkt = (split && half) ? (nt >> 1) : nt; u.mode = (split && half) ? (r == 0 ? 1 : 2) : 0; u.slot = x * (G >> 4) + q;
        const int nig = WGM * nN, gid = wgid / nig, fm = gid * WGM, gsz = (nM - fm) < WGM ? (nM - fm) : WGM;
        u.pm = fm + ((wgid % nig) % gsz); u.pn = (wgid % nig) / gsz; return ok;
    }
};

template <int ACT  > struct EpiBf16 {
    static constexpr bool PERM = true;
    bf16_t* O; int ldc;
    __device__ __forceinline__ void operator()(const f32x4 (&acc)[2][2][4][2], const Unit& u, int wr, int wc, int fr, int fq) const {
        const int row0 = u.pm * BM + wr * 64 + fr; const int col0 = u.pn * BM + wc * 32 + 8 * fq;
        if (ACT == 0 && u.pn >= 24) {
            const int colq = 6144 + (u.pn - 24) * HALF + wc * 32 + 8 * fq;
#pragma unroll
            for (int ai = 0; ai < 2; ++ai)
#pragma unroll
                for (int m = 0; m < 4; ++m) { const f32x4 v0 = acc[ai][0][m][0] * acc[ai][1][m][0], v1 = acc[ai][0][m][1] * acc[ai][1][m][1];
                    u32x4 w; w.x = cvt_pk_bf16(v0[0], v0[1]); w.y = cvt_pk_bf16(v0[2], v0[3]); w.z = cvt_pk_bf16(v1[0], v1[1]); w.w = cvt_pk_bf16(v1[2], v1[3]);
                    *(u32x4*)(O + (size_t)(row0 + ai * HALF + m * 16) * ldc + colq) = w; }
            return;
        }
#pragma unroll
        for (int ai = 0; ai < 2; ++ai)
#pragma unroll
            for (int m = 0; m < 4; ++m) { bf16_t* rowp = O + (size_t)(row0 + ai * HALF + m * 16) * ldc + col0;
#pragma unroll
                for (int bj = 0; bj < 2; ++bj) { f32x4 v0 = acc[ai][bj][m][0], v1 = acc[ai][bj][m][1];
                    if (ACT == 0) { if (u.pn < 4 || (u.pn >= 16 && u.pn < 20)) {
#pragma unroll
                        for (int j = 0; j < 4; ++j) { v0[j] = v0[j] * __builtin_amdgcn_rcpf(1.0f + __builtin_amdgcn_exp2f(v0[j] * -1.44269504f)); v1[j] = v1[j] * __builtin_amdgcn_rcpf(1.0f + __builtin_amdgcn_exp2f(v1[j] * -1.44269504f)); } } }
                    if (ACT == 1) {
#pragma unroll
                        for (int j = 0; j < 4; ++j) { const float a = fmaxf(v0[j], 0.f), b = fmaxf(v1[j], 0.f); v0[j] = a * a; v1[j] = b * b; } }
                    u32x4 w; w.x = cvt_pk_bf16(v0[0], v0[1]); w.y = cvt_pk_bf16(v0[2], v0[3]); w.z = cvt_pk_bf16(v1[0], v1[1]); w.w = cvt_pk_bf16(v1[2], v1[3]);
                    *(u32x4*)(rowp + bj * HALF) = w; } }
    }
};
struct EpiRes {
    static constexpr bool PERM = true;
    const float* xp; const float* xs; const bf16_t* xin; bf16_t* xout; const float* mod; int gate_off; int layer0;
    __device__ __forceinline__ void operator()(const f32x4 (&acc)[2][2][4][2], const Unit& u, int wr, int wc, int fr, int fq) const {
        const int grp = u.pm < 16 ? 0 : (u.pm < 32 ? 1 : 2);
        const float* gate = mod + grp * MODW + gate_off;
        const float* base = u.pm < 16 ? xp + (size_t)u.pm * BM * DM : xs + (size_t)(u.pm - 16) * BM * DM;
        const bf16_t* baseb = xin + (size_t)u.pm * BM * DM;
        bf16_t* out = xout + (size_t)u.pm * BM * DM;
        const int row0 = wr * 64 + fr, col0 = u.pn * BM + wc * 32 + 8 * fq;
        f32x4 gv[2][2];
#pragma unroll
        for (int bj = 0; bj < 2; ++bj)
#pragma unroll
            for (int n = 0; n < 2; ++n) gv[bj][n] = *(const f32x4*)(gate + col0 + bj * HALF + 4 * n);
#pragma unroll
        for (int ai = 0; ai < 2; ++ai)
#pragma unroll
            for (int m = 0; m < 4; ++m) { const size_t off = (size_t)(row0 + ai * HALF + m * 16) * DM + col0;
#pragma unroll
                for (int bj = 0; bj < 2; ++bj) {
                    f32x4 b0, b1;
                    if (layer0) { b0 = *(const f32x4*)(base + off + bj * HALF); b1 = *(const f32x4*)(base + off + bj * HALF + 4); }
                    else { float t8[8]; unpack8(*(const u32x4*)(baseb + off + bj * HALF), t8); b0 = (f32x4){t8[0], t8[1], t8[2], t8[3]}; b1 = (f32x4){t8[4], t8[5], t8[6], t8[7]}; }
                    const f32x4 y0 = b0 + gv[bj][0] * acc[ai][bj][m][0], y1 = b1 + gv[bj][1] * acc[ai][bj][m][1];
                    *(u32x4*)(out + off + bj * HALF) = (u32x4){cvt_pk_bf16(y0.x, y0.y), cvt_pk_bf16(y0.z, y0.w), cvt_pk_bf16(y1.x, y1.y), cvt_pk_bf16(y1.z, y1.w)}; }
                asm volatile("" ::: "memory"); }
    }
};

template <class Epi, class Sched, bool SPLIT>
__device__ __forceinline__ void gemm_phase(LAS unsigned char* lds, const Gemm g, const Sched& S, const Epi& E, const int tid) {
    const int wid = __builtin_amdgcn_readfirstlane(tid >> 6), lane = tid & 63, wr = wid >> 2, wc = wid & 3, fr = lane & 15, fq = lane >> 4;
    const int K = g.K;
    unsigned voffA[2], voffB[2];
#pragma unroll
    for (int i = 0; i < 2; ++i) { int R, C; stage_rc(tid * 16 + i * 8192, R, C); const int Rb = Epi::PERM ? ((R & ~31) + perm32(R & 31)) : R;
        voffA[i] = (unsigned)(R * K + C) * 2u; voffB[i] = (unsigned)(Rb * K + C) * 2u; }
    const size_t kstep = (size_t)(BK * 2);
    const size_t hstep = (size_t)HALF * K * 2;
    const size_t tstep = 2 * hstep;
    const unsigned ldsw = (unsigned)wid * 1024u;
    const int aoff = lds_byte(wr * 64 + fr, fq * 8), boff = lds_byte(wc * 32 + fr, fq * 8);
#define PG8_SA(b, h) (((b) * 2 + (h)) * HTB)
#define PG8_SB(b, h) ((4 + (b) * 2 + (h)) * HTB)
#define PG8_STAGE(bufoff, gbase, voff) do { _Pragma("unroll") for (int _i = 0; _i < 2; ++_i) \
        __builtin_amdgcn_global_load_lds((const unsigned*)((const char*)(gbase) + (voff)[_i]), (LAS unsigned*)(lds + (bufoff) + ldsw + _i * 8192), 16, 0, 0); } while (0)
#define PG8_LDA(dst, b, h) do { _Pragma("unroll") for (int m = 0; m < 4; ++m) _Pragma("unroll") for (int k = 0; k < 2; ++k) dst[m][k] = *(const LAS bf16x8*)(lds + PG8_SA(b, h) + aoff + m * 2048 + k * 1024); } while (0)
#define PG8_LDB(dst, b, h) do { _Pragma("unroll") for (int n = 0; n < 2; ++n) _Pragma("unroll") for (int k = 0; k < 2; ++k) dst[n][k] = *(const LAS bf16x8*)(lds + PG8_SB(b, h) + boff + n * 2048 + k * 1024); } while (0)
#define PG8_MMA(ai, bj, At, Bt) do { __builtin_amdgcn_s_setprio(1); _Pragma("unroll") for (int m = 0; m < 4; ++m) _Pragma("unroll") for (int n = 0; n < 2; ++n) _Pragma("unroll") for (int k = 0; k < 2; ++k) \
        acc[ai][bj][m][n] = __builtin_amdgcn_mfma_f32_16x16x32_bf16(Bt[n][k], At[m][k], acc[ai][bj][m][n], 0, 0, 0); __builtin_amdgcn_s_setprio(0); } while (0)
#define PG8_WAIT_V(n) asm volatile("s_waitcnt vmcnt(" #n ")" ::: "memory")
#define PG8_WAIT_L(n) asm volatile("s_waitcnt lgkmcnt(" #n ")" ::: "memory")
#define PG8_BAR __builtin_amdgcn_s_barrier()
#define PG8_SCHED __builtin_amdgcn_sched_barrier(0)
    Unit cur, nxt; int ui = 0;
    if (!S.next(0, cur)) return;
    f32x4 acc[2][2][4][2];
#pragma unroll
    for (int a = 0; a < 2; ++a)
#pragma unroll
        for (int b = 0; b < 2; ++b)
#pragma unroll
            for (int m = 0; m < 4; ++m)
#pragma unroll
                for (int n = 0; n < 2; ++n) acc[a][b][m][n] = (f32x4){0.f, 0.f, 0.f, 0.f};
    bf16x8 At[4][2], B0[2][2], B1[2][2];
    const char* cA = (const char*)g.A + (size_t)cur.pm * tstep + (size_t)cur.kt0 * kstep; const char* cB = (const char*)g.Bt + (size_t)cur.pn * tstep + (size_t)cur.kt0 * kstep;
    PG8_STAGE(PG8_SB(0, 0), cB, voffB); PG8_STAGE(PG8_SA(0, 0), cA, voffA); PG8_STAGE(PG8_SB(0, 1), cB + hstep, voffB); PG8_STAGE(PG8_SA(0, 1), cA + hstep, voffA);
    if (wr == 1) PG8_BAR;
    PG8_WAIT_V(4); PG8_BAR;
    PG8_STAGE(PG8_SB(1, 0), cB + kstep, voffB); PG8_STAGE(PG8_SA(1, 0), cA + kstep, voffA); PG8_STAGE(PG8_SB(1, 1), cB + hstep + kstep, voffB);
    PG8_WAIT_V(6); PG8_BAR;
    for (;;) {
        const bool has_next = S.next(ui + 1, nxt);
        const char* nA = has_next ? (const char*)g.A + (size_t)nxt.pm * tstep + (size_t)nxt.kt0 * kstep : cA; const char* nB = has_next ? (const char*)g.Bt + (size_t)nxt.pn * tstep + (size_t)nxt.kt0 * kstep : cB;
        const int nt = cur.nkt;
        for (int t = 0; t < nt; t += 2) {
            const bool last = (t == nt - 2);
            const char* a1 = cA + (size_t)(t + 1) * kstep;
            const char* a2 = last ? nA : cA + (size_t)(t + 2) * kstep; const char* b2 = last ? nB : cB + (size_t)(t + 2) * kstep;
            const char* a3 = a2 + kstep; const char* b3 = b2 + kstep;
            PG8_LDB(B0, 0, 0); PG8_SCHED; PG8_LDA(At, 0, 0); PG8_STAGE(PG8_SA(1, 1), a1 + hstep, voffA);
            PG8_WAIT_L(8); PG8_BAR; PG8_WAIT_L(0); PG8_MMA(0, 0, At, B0); PG8_BAR; PG8_SCHED;
            PG8_LDB(B1, 0, 1); PG8_STAGE(PG8_SB(0, 0), b2, voffB);
            PG8_BAR; PG8_WAIT_L(0); PG8_MMA(0, 1, At, B1); PG8_BAR;
            PG8_LDA(At, 0, 1); PG8_STAGE(PG8_SA(0, 0), a2, voffA);
            PG8_BAR; PG8_WAIT_L(0); PG8_MMA(1, 0, At, B0); PG8_BAR; PG8_SCHED;
            PG8_STAGE(PG8_SB(0, 1), b2 + hstep, voffB);
            PG8_WAIT_V(6); PG8_BAR; PG8_MMA(1, 1, At, B1); PG8_BAR;
            PG8_LDB(B0, 1, 0); PG8_SCHED; PG8_LDA(At, 1, 0); PG8_STAGE(PG8_SA(0, 1), a2 + hstep, voffA);
            PG8_WAIT_L(8); PG8_BAR; PG8_WAIT_L(0); PG8_MMA(0, 0, At, B0); PG8_BAR; PG8_SCHED;
            PG8_LDB(B1, 1, 1); PG8_STAGE(PG8_SB(1, 0), b3, voffB);
            PG8_BAR; PG8_WAIT_L(0); PG8_MMA(0, 1, At, B1); PG8_BAR;
            PG8_LDA(At, 1, 1); PG8_STAGE(PG8_SA(1, 0), a3, voffA);
            PG8_BAR; PG8_WAIT_L(0); PG8_MMA(1, 0, At, B0); PG8_BAR; PG8_SCHED;
            PG8_STAGE(PG8_SB(1, 1), b3 + hstep, voffB);
            PG8_WAIT_V(6); PG8_BAR; PG8_MMA(1, 1, At, B1); PG8_BAR;
        }
        if (SPLIT && cur.mode != 0) {
            const bool wr_part = (cur.mode == 1);
            if (!wr_part) {
                unsigned sp_ = 0;
                while ((unsigned)__builtin_amdgcn_readfirstlane(__hip_atomic_load(g.flags + cur.slot * 16, __ATOMIC_RELAXED, __HIP_MEMORY_SCOPE_AGENT)) < 8u) { __builtin_amdgcn_s_sleep(2); if (++sp_ > (1u << 24)) break; }
                __builtin_amdgcn_fence(__ATOMIC_ACQUIRE, "agent");
                asm volatile("s_waitcnt vmcnt(0)" ::: "memory");
            }
            float* sp = g.part + (size_t)cur.slot * 65536 + tid * 4;
#pragma unroll
            for (int a = 0; a < 2; ++a)
#pragma unroll
                for (int b = 0; b < 2; ++b)
#pragma unroll
                    for (int m = 0; m < 4; ++m) {
#pragma unroll
                        for (int n = 0; n < 2; ++n) {
                            if (wr_part) *(f32x4*)sp = acc[a][b][m][n]; else acc[a][b][m][n] += *(const f32x4*)sp;
                            sp += 2048; asm volatile("" : "+v"(sp)); }
                        asm volatile("" ::: "memory"); }
            if (wr_part) {
                asm volatile("s_waitcnt vmcnt(0)" ::: "memory");
                __builtin_amdgcn_fence(__ATOMIC_RELEASE, "agent");
                asm volatile("s_waitcnt vmcnt(0)" ::: "memory");
                if (lane == 0) __hip_atomic_fetch_add(g.flags + cur.slot * 16, 1u, __ATOMIC_RELAXED, __HIP_MEMORY_SCOPE_AGENT);
            }
        }
        if (!(SPLIT && cur.mode == 1)) E(acc, cur, wr, wc, fr, fq);
        if (!has_next) break;
#pragma unroll
        for (int a = 0; a < 2; ++a)
#pragma unroll
            for (int b = 0; b < 2; ++b)
#pragma unroll
                for (int m = 0; m < 4; ++m)
#pragma unroll
                    for (int n = 0; n < 2; ++n) acc[a][b][m][n] = (f32x4){0.f, 0.f, 0.f, 0.f};
        cur = nxt; cA = nA; cB = nB; ++ui;
    }
    PG8_WAIT_V(0);
    if (wr == 0) PG8_BAR;
    PG8_BAR;
#undef PG8_SA
#undef PG8_SB
#undef PG8_STAGE
#undef PG8_LDA
#undef PG8_LDB
#undef PG8_MMA
#undef PG8_WAIT_V
#undef PG8_WAIT_L
#undef PG8_BAR
#undef PG8_SCHED
}
}

struct Args { const float* in[17]; float* out; unsigned char* ws; int ph_lo, ph_hi; };
typedef const __attribute__((address_space(4))) Args CArgs;
enum { I_XP = 0, I_XS, I_STATE, I_C, I_CCTX, I_N1G, I_N2G, I_WADA, I_BADA, I_WIN, I_LB, I_HGG, I_CONVW, I_WOUT, I_WM1, I_WM2, I_FING };

template <bool CUPAIR> __device__ __forceinline__ void p0_transpose_item(const float* __restrict__ W, int K, int N, bf16_t* __restrict__ WT, LAS float* scr, int item, int lane) {
    const int nblk = N / 32, kb = item / nblk, nb = item % nblk, k0 = 64 * kb, n0 = 32 * nb;
    int n0d = n0;
    if (CUPAIR && n0 >= 6144) { const int isu = n0 >= 7168 ? 1 : 0, ch0 = n0 - (isu ? 7168 : 6144); n0d = 6144 + 256 * (ch0 >> 7) + 128 * isu + (ch0 & 127); }
    float tmp[32];
#pragma unroll
    for (int i = 0; i < 32; ++i) { const int kk = 2 * i + (lane >> 5); tmp[i] = __builtin_nontemporal_load(&W[(size_t)(k0 + kk) * N + n0 + (lane & 31)]);   }
#pragma unroll
    for (int i = 0; i < 32; ++i) { const int kk = 2 * i + (lane >> 5); scr[kk * 33 + (lane & 31)] = tmp[i]; }
    LDS_WAIT(); asm volatile("" ::: "memory");
    const int c = lane & 7;
#pragma unroll
    for (int j = 0; j < 4; ++j) { const int n = (lane >> 3) + 8 * j; const LAS float* s = scr + (8 * c) * 33 + n;
        u32x4 o; o.x = cvt_pk_bf16(s[0 * 33], s[1 * 33]); o.y = cvt_pk_bf16(s[2 * 33], s[3 * 33]); o.z = cvt_pk_bf16(s[4 * 33], s[5 * 33]); o.w = cvt_pk_bf16(s[6 * 33], s[7 * 33]);
        *(u32x4*)(WT + (size_t)(n0d + n) * K + k0 + 8 * c) = o; }
    LDS_WAIT(); asm volatile("" ::: "memory");
}
constexpr int TI_IN = (DM / 64) * (INC / 32), TI_OUT = (DM / 64) * (DM / 32), TI_M1 = (DM / 64) * (DFF / 32), TI_M2 = (DFF / 64) * (DM / 32), TI_L = TI_IN + TI_OUT + TI_M1 + TI_M2;
__device__ __forceinline__ void transpose_dispatch(CArgs& a, int l, int r, LAS float* scr, int lane) {
    if (r < TI_IN) { p0_transpose_item<true>(a.in[I_WIN] + (size_t)l * DM * INC, DM, INC, (bf16_t*)(a.ws + WS_WIN) + (size_t)l * DM * INC, scr, r, lane); return; } r -= TI_IN;
    if (r < TI_OUT) { p0_transpose_item<false>(a.in[I_WOUT] + (size_t)l * DM * DM, DM, DM, (bf16_t*)(a.ws + WS_WOUT) + (size_t)l * DM * DM, scr, r, lane); return; } r -= TI_OUT;
    if (r < TI_M1) { p0_transpose_item<false>(a.in[I_WM1] + (size_t)l * DM * DFF, DM, DFF, (bf16_t*)(a.ws + WS_WM1) + (size_t)l * DM * DFF, scr, r, lane); return; } r -= TI_M1;
    p0_transpose_item<false>(a.in[I_WM2] + (size_t)l * DFF * DM, DFF, DM, (bf16_t*)(a.ws + WS_WM2) + (size_t)l * DFF * DM, scr, r, lane);
}
__device__ __forceinline__ void prologue_phase(CArgs& a, LAS unsigned char* lds, int tid, int wave, int lane, int G) {
    LAS float* sc = (LAS float*)lds;
    const float* w_ada = a.in[I_WADA]; float* modp = (float*)(a.ws + WS_MODP);
    for (int it = blockIdx.x; it < 2 * KS_ADA * 6; it += G) {
        const int l = it / (KS_ADA * 6), r = it % (KS_ADA * 6), ks = r / 6, cb = r % 6;
        __syncthreads();
        if (tid < 384) { const int g = tid >> 7, kk = tid & 127, k = 128 * ks + kk; const float cv = (g == 0) ? a.in[I_CCTX][k] : a.in[I_C][(g - 1) * DM + k]; sc[tid] = cv * sigmoidf_fast(cv); }
        __syncthreads();
        const int col = cb * 2048 + tid * 4;
        const float* wp = w_ada + ((size_t)l * DM + 128 * ks) * MODW + col;
        f32x4 a0 = {0.f, 0.f, 0.f, 0.f}, a1 = a0, a2 = a0;
#pragma unroll 8
        for (int kk = 0; kk < 128; ++kk) { const f32x4 w = __builtin_nontemporal_load((const f32x4*)(wp + (size_t)kk * MODW));   a0 += w * sc[kk]; a1 += w * sc[128 + kk]; a2 += w * sc[256 + kk]; }
        float* o = modp + (size_t)((l * KS_ADA + ks) * 3) * MODW + col;
        *(f32x4*)(o) = a0; *(f32x4*)(o + MODW) = a1; *(f32x4*)(o + 2 * MODW) = a2;
    }
    __syncthreads();
    LAS float* scr = (LAS float*)(lds + wave * 16384);
    constexpr int NIT = TI_IN + TI_OUT + TI_M1, NGEMV = 2 * KS_ADA * 6, XL = 7, XH = 15;
    const bool bal = (G == 256) && (NGEMV * 8 * XL + (256 - NGEMV) * 8 * XH == NIT);
    const bool light = (int)blockIdx.x < NGEMV;
    const int gw = blockIdx.x * 8 + wave;
    const int it0 = bal ? (light ? gw : NGEMV * 8 * XL + (gw - NGEMV * 8)) : gw;
    const int its = bal ? (light ? NGEMV * 8 : (256 - NGEMV) * 8) : G * 8;
    const int ite = bal ? (light ? NGEMV * 8 * XL : NIT) : NIT;
    for (int it = it0; it < ite; it += its) transpose_dispatch(a, 0, it, scr, lane);
}
__device__ __forceinline__ void side_transposes(CArgs& a, LAS unsigned char* lds, int lo, int hi, int wave, int lane, int G) {
    const int first = G >> 1; if ((int)blockIdx.x < first) return;
    LAS float* scr = (LAS float*)(lds + wave * 16384);
    for (int it = lo + ((int)blockIdx.x - first) * 8 + wave; it < hi; it += (G - first) * 8) transpose_dispatch(a, it / TI_L, it % TI_L, scr, lane);
}
__device__ __forceinline__ void finmod_phase(CArgs& a, int tid, int G) {
    const float* modp = (const float*)(a.ws + WS_MODP); float* mod = (float*)(a.ws + WS_MOD); const float* b_ada = a.in[I_BADA];
    for (int i = blockIdx.x * 512 + tid; i < 2 * 3 * MODW; i += G * 512) {
        const int l = i / (3 * MODW), r = i % (3 * MODW), g = r / MODW, c = r % MODW;
        float s = b_ada[l * MODW + c];
#pragma unroll
        for (int ks = 0; ks < KS_ADA; ++ks) s += modp[(size_t)((l * KS_ADA + ks) * 3 + g) * MODW + c];
        mod[i] = s;
    }
}

__device__ __forceinline__ const float* xrow_ptr(CArgs& a, int row) {
    return row < NCTX ? a.in[I_XP] + (size_t)row * DM : a.in[I_XS] + (size_t)(row - NCTX) * DM;
}
__device__ __forceinline__ void normmod_phase(CArgs& a, int layer0, const float* __restrict__ gvec, const float* __restrict__ mod, int sh_off, int sc_off, int wave, int lane, int G) {
    bf16_t* hb = (bf16_t*)(a.ws + WS_HB);
    const int gw = blockIdx.x * 8 + wave, NGW = G * 8;
    const int R = ((NTOK + NGW - 1) / NGW + 1) & ~1, rbeg = gw * R, rend = (rbeg + R < NTOK) ? rbeg + R : NTOK;
    int cur_grp = -1; f32x4 A[8], B[8];
    {
        for (int row = rbeg; row < rend; row += 2) {
            const int grp = row / NCTX;
            if (grp != cur_grp) { cur_grp = grp;
#pragma unroll
                for (int j = 0; j < 8; ++j) { const int col = (lane + 64 * j) * 4; const f32x4 g4 = *(const f32x4*)(gvec + col), s4 = *(const f32x4*)(mod + grp * MODW + sc_off + col);
                    A[j] = g4 * (s4 + 1.0f); B[j] = *(const f32x4*)(mod + grp * MODW + sh_off + col); } }
            const bool has2 = row + 1 < rend; const int row2 = has2 ? row + 1 : row;
            f32x4 v[8], w2[8]; float ss = 0.f, ss2 = 0.f;
            if (layer0) { const float* s0 = xrow_ptr(a, row); const float* s1 = xrow_ptr(a, row2);
#pragma unroll
                for (int j = 0; j < 8; ++j) { v[j] = *(const f32x4*)(s0 + (lane + 64 * j) * 4); w2[j] = *(const f32x4*)(s1 + (lane + 64 * j) * 4); } }
            else { const bf16_t* s0 = (const bf16_t*)(a.ws + WS_XRES) + (size_t)row * DM; const bf16_t* s1 = (const bf16_t*)(a.ws + WS_XRES) + (size_t)row2 * DM;
                u32x2 r0[8], r1[8];
#pragma unroll
                for (int j = 0; j < 8; ++j) { r0[j] = *(const u32x2*)(s0 + (lane + 64 * j) * 4); r1[j] = *(const u32x2*)(s1 + (lane + 64 * j) * 4); }
#pragma unroll
                for (int j = 0; j < 8; ++j) { v[j] = (f32x4){__uint_as_float(r0[j].x << 16), __uint_as_float(r0[j].x & 0xffff0000u), __uint_as_float(r0[j].y << 16), __uint_as_float(r0[j].y & 0xffff0000u)};
                                              w2[j] = (f32x4){__uint_as_float(r1[j].x << 16), __uint_as_float(r1[j].x & 0xffff0000u), __uint_as_float(r1[j].y << 16), __uint_as_float(r1[j].y & 0xffff0000u)}; } }
#pragma unroll
            for (int j = 0; j < 8; ++j) { ss += (v[j].x * v[j].x + v[j].y * v[j].y) + (v[j].z * v[j].z + v[j].w * v[j].w); ss2 += (w2[j].x * w2[j].x + w2[j].y * w2[j].y) + (w2[j].z * w2[j].z + w2[j].w * w2[j].w); }
            const float rstd = rsqrtf(wave_sum(ss) * (1.0f / DM) + EPS), rstd2 = rsqrtf(wave_sum(ss2) * (1.0f / DM) + EPS);
#pragma unroll
            for (int j = 0; j < 8; ++j) { const f32x4 y = v[j] * rstd * A[j] + B[j]; u32x2 w; w.x = cvt_pk_bf16(y.x, y.y); w.y = cvt_pk_bf16(y.z, y.w);
                *(u32x2*)(hb + (size_t)row * DM + (lane + 64 * j) * 4) = w; }
            if (has2) {
#pragma unroll
                for (int j = 0; j < 8; ++j) { const f32x4 y = w2[j] * rstd2 * A[j] + B[j]; u32x2 w; w.x = cvt_pk_bf16(y.x, y.y); w.y = cvt_pk_bf16(y.z, y.w);
                    *(u32x2*)(hb + (size_t)row2 * DM + (lane + 64 * j) * 4) = w; } }
        }
    }
}
__device__ __forceinline__ void final_phase(CArgs& a, int wave, int lane, int G) {
    const float* gvec = a.in[I_FING]; const bf16_t* xres = (const bf16_t*)(a.ws + WS_XRES);
    const int gw = blockIdx.x * 8 + wave, NGW = G * 8;
    f32x4 A[8];
#pragma unroll
    for (int j = 0; j < 8; ++j) A[j] = *(const f32x4*)(gvec + (lane + 64 * j) * 4);
    for (int row = gw; row < NTOK; row += 3 * NGW) {
        int rr[3]; bool ok[3];
#pragma unroll
        for (int k = 0; k < 3; ++k) { ok[k] = row + k * NGW < NTOK; rr[k] = ok[k] ? row + k * NGW : row; }
        u32x2 r[3][8];
#pragma unroll
        for (int k = 0; k < 3; ++k)
#pragma unroll
            for (int j = 0; j < 8; ++j) r[k][j] = *(const u32x2*)(xres + (size_t)rr[k] * DM + (lane + 64 * j) * 4);
#pragma unroll
        for (int k = 0; k < 3; ++k) {
            f32x4 v[8]; float ss = 0.f;
#pragma unroll
            for (int j = 0; j < 8; ++j) { v[j] = (f32x4){__uint_as_float(r[k][j].x << 16), __uint_as_float(r[k][j].x & 0xffff0000u), __uint_as_float(r[k][j].y << 16), __uint_as_float(r[k][j].y & 0xffff0000u)};
                ss += (v[j].x * v[j].x + v[j].y * v[j].y) + (v[j].z * v[j].z + v[j].w * v[j].w); }
            const float rstd = rsqrtf(wave_sum(ss) * (1.0f / DM) + EPS);
            if (ok[k]) {
#pragma unroll
                for (int j = 0; j < 8; ++j) *(f32x4*)(a.out + (size_t)rr[k] * DM + (lane + 64 * j) * 4) = v[j] * rstd * A[j]; }
        }
    }
}

constexpr int H_LF = 0, H_SQ = 16384, H_KK = 32768, H_QT = 49152, H_KT = 57856, H_KPT = 66560, H_VT = 76800  , H_PM = 97280, H_DD = 99840, H_OT = 100352  , H_LB = 117248  ;
constexpr int QS = 136;
constexpr int TS = 40;
constexpr int OTS = 132;
constexpr int VRS = 132;

__device__ __forceinline__ void hgrn_phase(CArgs& a, LAS unsigned char* lds, int l, int pass, int tid, int wave, int lane, int G) {
    const bf16_t* __restrict__ proj = (const bf16_t*)(a.ws + WS_PROJ);
    float* segL = (float*)(a.ws + WS_SEGL); float* segD = (float*)(a.ws + WS_SEGD);
    LAS float* LF = (LAS float*)(lds + H_LF); LAS bf16_t* SQR = (LAS bf16_t*)(lds + H_SQ);
    LAS bf16_t* QT = (LAS bf16_t*)(lds + H_QT); LAS bf16_t* KT = (LAS bf16_t*)(lds + H_KT); LAS bf16_t* KPT = (LAS bf16_t*)(lds + H_KPT);
    LAS bf16_t* PM = (LAS bf16_t*)(lds + H_PM); LAS float* DD = (LAS float*)(lds + H_DD); LAS float* OT = (LAS float*)(lds + H_OT); LAS float* LBV = (LAS float*)(lds + H_LB);
    const int n16 = lane & 15, kg = lane >> 4;
    const int tok = tid >> 4, c8 = tid & 15;
    const int dk = tid & 127, tq = wave >> 1;
    for (int i = tid; i < 32 * TS; i += 512) PM[i] = 0;
    const int nlat = (pass == 1) ? 32 * (NSEG - 1) : 32 * NSEG;
    const int nitems = (pass == 1) ? nlat : nlat + 256;
    for (int item = blockIdx.x; item < nitems; item += G) {
        int b, h, dir, T0, L, c0, nch, seg = 0, chain = 0; bool lat;
        if (item < nlat) { lat = true; const int ns = (pass == 1) ? (NSEG - 1) : NSEG; chain = item / ns; seg = item % ns; b = chain >> 4; h = (chain >> 1) & 7; dir = chain & 1; T0 = NCTX + b * 4096; L = 4096; c0 = seg * SEGCH; nch = SEGCH; }
        else { lat = false; const int j = item - nlat; b = j >> 4; h = (j >> 1) & 7; dir = j & 1; T0 = b * 256; L = 256; c0 = 0; nch = 8; }
        const bool want_out = (pass == 3);
        bf16_t* __restrict__ ofd = (bf16_t*)(a.ws + WS_OF) + (size_t)dir * NTOK * HW;
        u32x4 rq, rz, rv;
        { const int p = 32 * c0 + tok; const int row = T0 + (dir ? (L - 1 - p) : p); const bf16_t* bp = proj + (size_t)row * INC + h * 128 + c8 * 8;
          rq = *(const u32x4*)(bp); rv = *(const u32x4*)(bp + 1024); rz = *(const u32x4*)(bp + 2048 + dir * 1024); }
        __syncthreads();
        if (tid < 128) { float v = 0.f; if (l != 0) { const float l0 = a.in[I_LB][(0 * 2 + dir) * HW + h * 128 + tid], l1 = a.in[I_LB][(1 * 2 + dir) * HW + h * 128 + tid]; v = __builtin_amdgcn_rcpf(1.0f + __expf(l0 - l1)); } LBV[tid] = v; }
        f32x4 S[8];
#pragma unroll
        for (int t = 0; t < 8; ++t) S[t] = (f32x4){0.f, 0.f, 0.f, 0.f};
        if (lat && pass == 3) {
            const float* s0 = a.in[I_STATE] + ((size_t)(((b * 2 + l) * 2 + dir) * 8 + h)) * 16384 + wave * 16 + n16;
#pragma unroll
            for (int t = 0; t < 8; ++t)
#pragma unroll
                for (int j = 0; j < 4; ++j) S[t][j] = s0[(16 * t + 4 * kg + j) * 128];
            asm volatile("" ::: "memory");
#pragma unroll 2
            for (int sj = 0; sj < seg; ++sj) {
                const float* Lp = segL + (size_t)(chain * NSEG + sj) * 16384 + tid * 4; const float* Dp = segD + (size_t)(chain * NSEG + sj) * 128;
#pragma unroll
                for (int t = 0; t < 8; ++t) { const f32x4 d4 = *(const f32x4*)(Dp + 16 * t + 4 * kg); S[t] = S[t] * d4 + *(const f32x4*)(Lp + t * 2048); }
            }
        }
        float dprod = 1.f;
        __syncthreads();
#pragma unroll 1
        for (int ci = 0; ci < nch; ++ci) {
            const int c = c0 + ci;
            LAS bf16_t* VR = (LAS bf16_t*)(lds + H_VT + (ci & 1) * 10240);
            {
                float zf[8]; unpack8(rz, zf);
                float lf[8], lb[8];
                { const f32x4 b0 = *(const LAS f32x4*)(LBV + c8 * 8), b1 = *(const LAS f32x4*)(LBV + c8 * 8 + 4); lb[0] = b0.x; lb[1] = b0.y; lb[2] = b0.z; lb[3] = b0.w; lb[4] = b1.x; lb[5] = b1.y; lb[6] = b1.z; lb[7] = b1.w; }
#pragma unroll
                for (int i = 0; i < 8; ++i) {
                    const float sg = __builtin_amdgcn_rcpf(1.0f + __builtin_amdgcn_exp2f(zf[i] * -1.44269504f));
                    lf[i] = lb[i] + (1.0f - lb[i]) * sg;
                }
                const int o = tok * 128 + c8 * 8;
                *(LAS f32x4*)(LF + o) = (f32x4){lf[0], lf[1], lf[2], lf[3]}; *(LAS f32x4*)(LF + o + 4) = (f32x4){lf[4], lf[5], lf[6], lf[7]};
                if (want_out) *(LAS u32x4*)(SQR + o) = rq;
                *(LAS u32x2*)(VR + tok * VRS + c8 * 8) = (u32x2){rv.x, rv.y}; *(LAS u32x2*)(VR + tok * VRS + c8 * 8 + 4) = (u32x2){rv.z, rv.w};
            }
            if (ci + 1 < nch) { const int p = 32 * (c + 1) + tok; const int row = T0 + (dir ? (L - 1 - p) : p); const bf16_t* bp = proj + (size_t)row * INC + h * 128 + c8 * 8;
                rq = *(const u32x4*)(bp); rv = *(const u32x4*)(bp + 1024); rz = *(const u32x4*)(bp + 2048 + dir * 1024); }
            LBAR();
            if (want_out && ci > 0) {
                const int p = 32 * (c - 1) + tok; const int row = T0 + (dir ? (L - 1 - p) : p); bf16_t* op = ofd + (size_t)row * HW + h * 128 + c8 * 8;
                { const f32x4 x0 = *(const LAS f32x4*)(OT + tok * OTS + c8 * 8), x1 = *(const LAS f32x4*)(OT + tok * OTS + c8 * 8 + 4);
                  *(u32x4*)(op) = (u32x4){cvt_pk_bf16(x0.x, x0.y), cvt_pk_bf16(x0.z, x0.w), cvt_pk_bf16(x1.x, x1.y), cvt_pk_bf16(x1.z, x1.w)}; }
            }
            {
                float g4[4];
#pragma unroll
                for (int k = 0; k < 4; ++k) { float s = 1.f;
#pragma unroll
                    for (int j = 0; j < 8; ++j) s *= LF[(8 * k + j) * 128 + dk];
                    g4[k] = s; }
                const float dlast = (g4[0] * g4[1]) * (g4[2] * g4[3]);
                const float pre = (tq > 0 ? g4[0] : 1.f) * (tq > 1 ? g4[1] : 1.f) * (tq > 2 ? g4[2] : 1.f);
                const float post = (tq < 3 ? g4[3] : 1.f) * (tq < 2 ? g4[2] : 1.f) * (tq < 1 ? g4[1] : 1.f);
                float own[8], pfx[8], sfx[8];
#pragma unroll
                for (int j = 0; j < 8; ++j) own[j] = LF[(8 * tq + j) * 128 + dk];
                { float run = pre;
#pragma unroll
                  for (int j = 0; j < 8; ++j) { run *= own[j]; pfx[j] = run; }
                  run = post;
#pragma unroll
                  for (int j = 7; j >= 0; --j) { sfx[j] = run; run *= own[j]; } }
                float kp[8]; const float rdl = fminf(__builtin_amdgcn_rcpf(dlast), 1e34f);
#pragma unroll
                for (int j = 0; j < 8; ++j) { const int r = 8 * tq + j; const float k = 1.0f - own[j];
                    kp[j] = k * sfx[j];
                    if (want_out) { const float s = bf2f(SQR[r * 128 + dk]);
                        QT[r * QS + dk] = f2bf(s * pfx[j]); KT[r * QS + dk] = f2bf(kp[j] * rdl); } }
                u32x4 w; w.x = cvt_pk_bf16(kp[0], kp[1]); w.y = cvt_pk_bf16(kp[2], kp[3]); w.z = cvt_pk_bf16(kp[4], kp[5]); w.w = cvt_pk_bf16(kp[6], kp[7]);
                *(LAS u32x4*)(KPT + dk * TS + 8 * tq) = w;
                if (tq == 0) DD[dk] = dlast;
                dprod *= dlast;
            }
            LBAR();
            if (want_out) {
                if (wave < 3) {
                    const int mi = wave > 0 ? 1 : 0, ni = wave > 1 ? 1 : 0;
                    f32x4 pacc = {0.f, 0.f, 0.f, 0.f};
#pragma unroll
                    for (int ks = 0; ks < 4; ++ks) { const bf16x8 av = *(const LAS bf16x8*)(QT + (16 * mi + n16) * QS + 32 * ks + 8 * kg), bv = *(const LAS bf16x8*)(KT + (16 * ni + n16) * QS + 32 * ks + 8 * kg);
                        pacc = __builtin_amdgcn_mfma_f32_16x16x32_bf16(av, bv, pacc, 0, 0, 0); }
#pragma unroll
                    for (int j = 0; j < 4; ++j) { const int t = 16 * mi + 4 * kg + j, s = 16 * ni + n16; PM[t * TS + s] = f2bf(s <= t ? pacc[j] : 0.f); }
                }
                LBAR();
            }
            {
                bf16x8 vb;
                { const LAS bf16_t* vp = VR + (8 * kg) * VRS + 16 * wave + n16;
                  const u32x4 vw = {(unsigned)vp[0] | ((unsigned)vp[VRS] << 16), (unsigned)vp[2 * VRS] | ((unsigned)vp[3 * VRS] << 16), (unsigned)vp[4 * VRS] | ((unsigned)vp[5 * VRS] << 16), (unsigned)vp[6 * VRS] | ((unsigned)vp[7 * VRS] << 16)};
                  vb = __builtin_bit_cast(bf16x8, vw); }
                if (want_out) {
                    f32x4 o0 = {0.f, 0.f, 0.f, 0.f}, o1 = o0;
#pragma unroll
                    for (int ks = 0; ks < 4; ++ks) {
                        u32x4 sb; sb.x = cvt_pk_bf16(S[2 * ks][0], S[2 * ks][1]); sb.y = cvt_pk_bf16(S[2 * ks][2], S[2 * ks][3]); sb.z = cvt_pk_bf16(S[2 * ks + 1][0], S[2 * ks + 1][1]); sb.w = cvt_pk_bf16(S[2 * ks + 1][2], S[2 * ks + 1][3]);
                        const bf16x8 sbv = __builtin_bit_cast(bf16x8, sb);
                        u32x2 a0l = *(const LAS u32x2*)(QT + n16 * QS + 32 * ks + 4 * kg), a0h = *(const LAS u32x2*)(QT + n16 * QS + 32 * ks + 16 + 4 * kg);
                        u32x2 a1l = *(const LAS u32x2*)(QT + (16 + n16) * QS + 32 * ks + 4 * kg), a1h = *(const LAS u32x2*)(QT + (16 + n16) * QS + 32 * ks + 16 + 4 * kg);
                        const u32x4 A0 = {a0l.x, a0l.y, a0h.x, a0h.y}, A1 = {a1l.x, a1l.y, a1h.x, a1h.y};
                        o0 = __builtin_amdgcn_mfma_f32_16x16x32_bf16(__builtin_bit_cast(bf16x8, A0), sbv, o0, 0, 0, 0);
                        o1 = __builtin_amdgcn_mfma_f32_16x16x32_bf16(__builtin_bit_cast(bf16x8, A1), sbv, o1, 0, 0, 0);
                    }
                    const bf16x8 p0 = *(const LAS bf16x8*)(PM + n16 * TS + 8 * kg), p1 = *(const LAS bf16x8*)(PM + (16 + n16) * TS + 8 * kg);
                    o0 = __builtin_amdgcn_mfma_f32_16x16x32_bf16(p0, vb, o0, 0, 0, 0);
                    o1 = __builtin_amdgcn_mfma_f32_16x16x32_bf16(p1, vb, o1, 0, 0, 0);
#pragma unroll
                    for (int j = 0; j < 4; ++j) { OT[(4 * kg + j) * OTS + 16 * wave + n16] = o0[j]; OT[(16 + 4 * kg + j) * OTS + 16 * wave + n16] = o1[j]; }
                }
#pragma unroll
                for (int t = 0; t < 8; ++t) {
                    const f32x4 d4 = *(const LAS f32x4*)(DD + 16 * t + 4 * kg);
                    const bf16x8 ka = *(const LAS bf16x8*)(KPT + (16 * t + n16) * TS + 8 * kg);
                    S[t] = __builtin_amdgcn_mfma_f32_16x16x32_bf16(ka, vb, S[t] * d4, 0, 0, 0);
                }
            }
        }
        if (want_out) {
            __syncthreads();
            const int p = 32 * (c0 + nch - 1) + tok; const int row = T0 + (dir ? (L - 1 - p) : p); bf16_t* op = ofd + (size_t)row * HW + h * 128 + c8 * 8;
            { const f32x4 x0 = *(const LAS f32x4*)(OT + tok * OTS + c8 * 8), x1 = *(const LAS f32x4*)(OT + tok * OTS + c8 * 8 + 4);
              *(u32x4*)(op) = (u32x4){cvt_pk_bf16(x0.x, x0.y), cvt_pk_bf16(x0.z, x0.w), cvt_pk_bf16(x1.x, x1.y), cvt_pk_bf16(x1.z, x1.w)}; }
        }
        if (pass == 1) {
            float* Lp = segL + (size_t)(chain * NSEG + seg) * 16384 + tid * 4;
#pragma unroll
            for (int t = 0; t < 8; ++t) *(f32x4*)(Lp + t * 2048) = S[t];
            if (tq == 0) segD[(size_t)(chain * NSEG + seg) * 128 + dk] = dprod;
        } else if (!lat) {
            float* sp = a.out + (size_t)NTOK * DM + ((size_t)(((b * 2 + l) * 2 + dir) * 8 + h)) * 16384 + wave * 16 + n16;
#pragma unroll
            for (int t = 0; t < 8; ++t)
#pragma unroll
                for (int j = 0; j < 4; ++j) sp[(16 * t + 4 * kg + j) * 128] = S[t][j];
        }
    }
}

__device__ __forceinline__ void combine_phase(CArgs& a, int l, int wave, int lane, int G) {
    const bf16_t* __restrict__ proj = (const bf16_t*)(a.ws + WS_PROJ);
    const bf16_t* __restrict__ of = (const bf16_t*)(a.ws + WS_OF); const bf16_t* __restrict__ ob = of + (size_t)NTOK * HW;
    bf16_t* hb = (bf16_t*)(a.ws + WS_HB);
    const float* hgg = a.in[I_HGG] + l * HW + 16 * lane; const float* cw = a.in[I_CONVW] + l * 3 * HW + 16 * lane;
    const int gw = blockIdx.x * 8 + wave, NGW = G * 8;
    for (int t = gw; t < NTOK; t += NGW) {
        float o[16]; float ss = 0.f;
#pragma unroll
        for (int q = 0; q < 2; ++q) { float xf[8], xb[8]; unpack8(*(const u32x4*)(of + (size_t)t * HW + 16 * lane + 8 * q), xf); unpack8(*(const u32x4*)(ob + (size_t)t * HW + 16 * lane + 8 * q), xb);
#pragma unroll
            for (int i = 0; i < 8; ++i) { const float x = xf[i] + xb[i]; o[8 * q + i] = x; ss += x * x; } }
        ss += __shfl_xor(ss, 1); ss += __shfl_xor(ss, 2); ss += __shfl_xor(ss, 4);
        const float rstd = rsqrtf(ss * (1.0f / 128.0f) + EPS);
        const bf16_t* pr = proj + (size_t)t * INC + 16 * lane;
        float gf[16]; { float t8[8]; unpack8(*(const u32x4*)(pr + 4096), t8); for (int i = 0; i < 8; ++i) gf[i] = t8[i]; unpack8(*(const u32x4*)(pr + 4096 + 8), t8); for (int i = 0; i < 8; ++i) gf[8 + i] = t8[i]; }
        unsigned w[8];
#pragma unroll
        for (int i = 0; i < 8; ++i) { const float y0 = o[2 * i] * rstd * hgg[2 * i] * gf[2 * i], y1 = o[2 * i + 1] * rstd * hgg[2 * i + 1] * gf[2 * i + 1]; w[i] = cvt_pk_bf16(y0, y1); }
        *(u32x4*)(hb + (size_t)t * DM + 16 * lane) = (u32x4){w[0], w[1], w[2], w[3]}; *(u32x4*)(hb + (size_t)t * DM + 16 * lane + 8) = (u32x4){w[4], w[5], w[6], w[7]};
        int st; bool hp, hn;
        if (t < NCTX) { const int i = t & 255; st = 1; hp = i != 0; hn = i != 255; }
        else { const int i = (t - NCTX) & 4095; if ((l & 1) == 0) { const int cc = i & 63; st = 1; hp = cc != 0; hn = cc != 63; } else { st = 64; hp = i >= 64; hn = i < 4096 - 64; } }
        float uc[16], up[16], un[16], bb[16];
        { float x8[8];
#pragma unroll
          for (int hlf = 0; hlf < 2; ++hlf) {
            unpack8(*(const u32x4*)(pr + 6144 + 8 * hlf), x8);
#pragma unroll
            for (int i = 0; i < 8; ++i) uc[8 * hlf + i] = x8[i];
            if (hp) { unpack8(*(const u32x4*)(pr - (size_t)st * INC + 6144 + 8 * hlf), x8);
#pragma unroll
                for (int i = 0; i < 8; ++i) up[8 * hlf + i] = x8[i]; }
            else {
#pragma unroll
                for (int i = 0; i < 8; ++i) up[8 * hlf + i] = 0.f; }
            if (hn) { unpack8(*(const u32x4*)(pr + (size_t)st * INC + 6144 + 8 * hlf), x8);
#pragma unroll
                for (int i = 0; i < 8; ++i) un[8 * hlf + i] = x8[i]; }
            else {
#pragma unroll
                for (int i = 0; i < 8; ++i) un[8 * hlf + i] = 0.f; }
            unpack8(*(const u32x4*)(pr + 5120 + 8 * hlf), x8);
#pragma unroll
            for (int i = 0; i < 8; ++i) bb[8 * hlf + i] = x8[i];
          } }
#pragma unroll
        for (int i = 0; i < 8; ++i) {
            const float y0 = bb[2 * i] * (cw[2 * i] * up[2 * i] + cw[HW + 2 * i] * uc[2 * i] + cw[2 * HW + 2 * i] * un[2 * i]);
            const float y1 = bb[2 * i + 1] * (cw[2 * i + 1] * up[2 * i + 1] + cw[HW + 2 * i + 1] * uc[2 * i + 1] + cw[2 * HW + 2 * i + 1] * un[2 * i + 1]);
            w[i] = cvt_pk_bf16(y0, y1); }
        *(u32x4*)(hb + (size_t)t * DM + HW + 16 * lane) = (u32x4){w[0], w[1], w[2], w[3]}; *(u32x4*)(hb + (size_t)t * DM + HW + 16 * lane + 8) = (u32x4){w[4], w[5], w[6], w[7]};
    }
}

#define XB_TMO      128
#define XB_XCNT(j)  (256  + 64 * (j))
#define XB_XSUB(j)  (1280 + 64 * (j))
#define XB_XGEN(j)  (2304 + 64 * (j))
#define XB_TOP      3328
#define XB_TOPGEN   3392
#define XCD_BAR_WORDS 3456
#define SPLIT_FLAG_BASE 4096
#define CTL_WORDS (4096 + 4 * 128 * 16)
#define XB_SPIN_CAP (1u << 22)
__device__ __forceinline__ unsigned xb_ld(unsigned* p)              { return __hip_atomic_load(p, __ATOMIC_RELAXED, __HIP_MEMORY_SCOPE_AGENT); }
__device__ __forceinline__ unsigned xb_add(unsigned* p, unsigned v) { return __hip_atomic_fetch_add(p, v, __ATOMIC_RELAXED, __HIP_MEMORY_SCOPE_AGENT); }
__device__ __forceinline__ unsigned xb_xcc_id() { return (unsigned)__builtin_amdgcn_s_getreg((3 << 11) | 20) & 0xFu; }
#define XB_SPIN(cond, bar) do { unsigned _sp = 0; while (cond) { __builtin_amdgcn_s_sleep(1); \
    if ((++_sp & 255u) == 0u) { if (xb_ld(&(bar)[XB_TMO])) break; if (_sp > XB_SPIN_CAP) { atomicAdd(&(bar)[XB_TMO], 1u); break; } } } } while (0)
struct XcdBarrier { unsigned* bar; unsigned x; volatile LAS unsigned* st; };
__device__ __forceinline__ XcdBarrier xcd_barrier_post(unsigned* bar, volatile LAS unsigned* st) {
    XcdBarrier b; b.bar = bar; b.x = xb_xcc_id(); b.st = st;
    if (threadIdx.x == 0) (void)xb_add(&bar[XB_XCNT(b.x)], 1u);
    return b;
}
__device__ __forceinline__ void xcd_barrier_complete(unsigned* bar, unsigned x, unsigned& nloc, unsigned& nx) {
    const unsigned G = gridDim.x * gridDim.y * gridDim.z;
    unsigned sum, cnt, mine, sp = 0u;
    for (;;) {
        sum = 0u; cnt = 0u; mine = 0u;
#pragma unroll
        for (unsigned j = 0; j < 16; ++j) { const unsigned c = xb_ld(&bar[XB_XCNT(j)]); sum += c; cnt += (c > 0u) ? 1u : 0u; mine = (j == x) ? c : mine; }
        if (sum == G) break;
        __builtin_amdgcn_s_sleep(1);
        if ((++sp & 255u) == 0u) { if (xb_ld(&bar[XB_TMO])) break; if (sp > XB_SPIN_CAP) { atomicAdd(&bar[XB_TMO], 1u); break; } }
    }
    nloc = mine > 0u ? mine : 1u; nx = cnt > 0u ? cnt : 1u;
}
__device__ __forceinline__ void xcd_barrier(const XcdBarrier& b) {
    asm volatile("s_waitcnt vmcnt(0)" ::: "memory");
    __syncthreads();
    if (threadIdx.x == 0) {
        unsigned* bar = b.bar;
        __builtin_amdgcn_s_waitcnt(0);
        unsigned nloc = b.st[0], nx = b.st[1];
        if (nloc == 0u) { xcd_barrier_complete(bar, b.x, nloc, nx); b.st[0] = nloc; b.st[1] = nx; }
        const unsigned old = xb_add(&bar[XB_XSUB(b.x)], 1u);
        const unsigned gen = old / nloc;
        if (old + 1u == (gen + 1u) * nloc) {
            __builtin_amdgcn_fence(__ATOMIC_RELEASE, "agent");
            asm volatile("s_waitcnt vmcnt(0)" ::: "memory");
            const unsigned og = xb_add(&bar[XB_TOP], 1u);
            const unsigned tg = og / nx;
            if (og + 1u == (tg + 1u) * nx) xb_add(&bar[XB_TOPGEN], 1u);
            else XB_SPIN(xb_ld(&bar[XB_TOPGEN]) == tg, bar);
            __builtin_amdgcn_fence(__ATOMIC_ACQUIRE, "agent");
            xb_add(&bar[XB_XGEN(b.x)], 1u);
            asm volatile("s_waitcnt vmcnt(0)" ::: "memory");
        } else {
            XB_SPIN(xb_ld(&bar[XB_XGEN(b.x)]) == gen, bar);
            __builtin_amdgcn_fence(__ATOMIC_ACQUIRE, "agent");
            asm volatile("s_waitcnt vmcnt(0)" ::: "memory");
        }
    }
    __syncthreads();
}

__global__ void __launch_bounds__(512, 2) fwd_kernel(Args a) {
    extern __shared__ __attribute__((aligned(16))) unsigned char lds_raw[];
    LAS unsigned char* lds = (LAS unsigned char*)lds_raw;
    const int G = gridDim.x;
    cg::grid_group grid = cg::this_grid();
#define HB ((bf16_t*)(a.ws + WS_HB))
#define PROJ ((bf16_t*)(a.ws + WS_PROJ))
#define XRES ((bf16_t*)(a.ws + WS_XRES))
#define PH(p) (a.ph_lo <= (p) && (p) < a.ph_hi)
#define TIDS() CArgs* lap_ = (CArgs*)__builtin_amdgcn_kernarg_segment_ptr(); asm volatile("" : "+s"(lap_)); CArgs& a = *lap_; int tid = threadIdx.x; asm volatile("" : "+v"(tid)); const int lane = tid & 63, wave = __builtin_amdgcn_readfirstlane(tid >> 6); (void)lane; (void)wave
    volatile LAS unsigned* bst = (volatile LAS unsigned*)(lds + LDS_BYTES - 64);
    if (threadIdx.x == 0) { bst[0] = 0u; bst[1] = 0u; }
    unsigned* barw = (unsigned*)(a.ws + WS_BAR);
    const bool single = (a.ph_hi - a.ph_lo) > 1;
    __syncthreads();
    XcdBarrier xbar; xbar.bar = barw; xbar.x = 0; xbar.st = bst;
    if (single) xbar = xcd_barrier_post(barw, bst);
    if (a.ph_hi < 0) grid.sync();
#define SEAM(p) do { if ((p) + 1 < a.ph_hi) xcd_barrier(xbar); } while (0)
    if (PH(0)) { TIDS(); for (int rep = 0; rep < REP_PRO; ++rep) prologue_phase(a, lds, tid, wave, lane, G); SEAM(0); }
    if (PH(1)) { TIDS(); finmod_phase(a, tid, G); SEAM(1); }
#pragma unroll
    for (int l = 0; l < 2; ++l) {
        const int p0 = 2 + 9 * l;
#define mod ((const float*)(a.ws + WS_MOD) + (size_t)l * 3 * MODW)
        if (PH(p0 + 0)) { TIDS(); for (int rep = 0; rep < REP_MISC; ++rep) normmod_phase(a, l == 0, a.in[I_N1G] + l * DM, mod, 0 * DM, 1 * DM, wave, lane, G); SEAM(p0 + 0); }
        if (PH(p0 + 1)) { TIDS(); pg8::Gemm g{HB, (const bf16_t*)(a.ws + WS_WIN) + (size_t)l * DM * INC, NTOK, INC, DM, nullptr, nullptr}; pg8::StaticOrder S; S.init(NTOK, INC, DM, G, (int)blockIdx.x);
                  pg8::EpiBf16<0> E{PROJ, INC}; for (int rep = 0; rep < REP_GBIG; ++rep) pg8::gemm_phase<decltype(E), pg8::StaticOrder, false>(lds, g, S, E, tid); SEAM(p0 + 1); }
        if (PH(p0 + 2)) { TIDS(); if (NSEG > 1) for (int rep = 0; rep < REP_H1; ++rep) hgrn_phase(a, lds, l, 1, tid, wave, lane, G); SEAM(p0 + 2); }
        if (PH(p0 + 3)) { TIDS(); for (int rep = 0; rep < REP_HG; ++rep) hgrn_phase(a, lds, l, 3, tid, wave, lane, G); SEAM(p0 + 3); }
        if (PH(p0 + 4)) { TIDS(); for (int rep = 0; rep < REP_CB; ++rep) combine_phase(a, l, wave, lane, G); SEAM(p0 + 4); }
        if (PH(p0 + 5)) { TIDS(); pg8::Gemm g{HB, (const bf16_t*)(a.ws + WS_WOUT) + (size_t)l * DM * DM, NTOK, DM, DM, (float*)(a.ws + WS_PART), (unsigned*)(a.ws + WS_BAR) + SPLIT_FLAG_BASE + (l * 2 + 0) * 2048}; pg8::StaticOrder S; S.init(NTOK, DM, DM, G, (int)blockIdx.x);
                  pg8::EpiRes E{a.in[I_XP], a.in[I_XS], XRES, XRES, mod, 2 * DM, l == 0}; pg8::gemm_phase<pg8::EpiRes, pg8::StaticOrder, false>(lds, g, S, E, tid);
                  if (l == 0) side_transposes(a, lds, TI_IN + TI_OUT + TI_M1, TI_L, wave, lane, G); SEAM(p0 + 5); }
        if (PH(p0 + 6)) { TIDS(); for (int rep = 0; rep < REP_MISC; ++rep) normmod_phase(a, 0, a.in[I_N2G] + l * DM, mod, 3 * DM, 4 * DM, wave, lane, G); SEAM(p0 + 6); }
        if (PH(p0 + 7)) { TIDS(); pg8::Gemm g{HB, (const bf16_t*)(a.ws + WS_WM1) + (size_t)l * DM * DFF, NTOK, DFF, DM, nullptr, nullptr}; pg8::StaticOrder S; S.init(NTOK, DFF, DM, G, (int)blockIdx.x);
                  pg8::EpiBf16<1> E{PROJ, DFF}; for (int rep = 0; rep < REP_GBIG; ++rep) pg8::gemm_phase<decltype(E), pg8::StaticOrder, false>(lds, g, S, E, tid); SEAM(p0 + 7); }
        if (PH(p0 + 8)) { TIDS(); pg8::Gemm g{PROJ, (const bf16_t*)(a.ws + WS_WM2) + (size_t)l * DFF * DM, NTOK, DM, DFF, (float*)(a.ws + WS_PART), (unsigned*)(a.ws + WS_BAR) + SPLIT_FLAG_BASE + (l * 2 + 1) * 2048}; pg8::StaticOrder S; S.init(NTOK, DM, DFF, G, (int)blockIdx.x);
                  pg8::EpiRes E{a.in[I_XP], a.in[I_XS], XRES, XRES, mod, 5 * DM, 0}; pg8::gemm_phase<pg8::EpiRes, pg8::StaticOrder, false>(lds, g, S, E, tid);
                  if (l == 0) side_transposes(a, lds, TI_L, 2 * TI_L, wave, lane, G); SEAM(p0 + 8); }
    }
    if (PH(20)) { TIDS(); for (int rep = 0; rep < REP_MISC; ++rep) final_phase(a, wave, lane, G); }
}

extern "C" void kernel_launch(void* const* d_in, const int* in_sizes, int n_in, void* d_out, int out_size, void* d_ws, size_t ws_size, hipStream_t stream) {
    static int grid = 0;
    if (grid == 0) {
        if (n_in != 17 || ws_size < WS_END) { fprintf(stderr, "kernel_launch: expected 17 inputs and >= %zu bytes of workspace, got %d / %zu\n", (size_t)WS_END, n_in, ws_size); grid = -1; return; }
        int dev = 0, cus = 0, per_cu = 0;
        hipGetDevice(&dev); hipDeviceGetAttribute(&cus, hipDeviceAttributeMultiprocessorCount, dev);
        if (hipFuncSetAttribute((const void*)fwd_kernel, hipFuncAttributeMaxDynamicSharedMemorySize, LDS_BYTES) != hipSuccess) { fprintf(stderr, "kernel_launch: hipFuncSetAttribute failed\n"); grid = -1; return; }
        if (hipOccupancyMaxActiveBlocksPerMultiprocessor(&per_cu, (const void*)fwd_kernel, 512, LDS_BYTES) != hipSuccess || per_cu < 1) { fprintf(stderr, "kernel_launch: occupancy query gave %d\n", per_cu); per_cu = 1; }
        (void)hipGetLastError();
        grid = cus * per_cu;
        fprintf(stderr, "kernel_launch: grid %d (%d CUs x %d)\n", grid, cus, per_cu);
    }
    if (grid < 0) return;
    Args a{};
    for (int i = 0; i < 17; ++i) a.in[i] = (const float*)d_in[i];
    a.out = (float*)d_out; a.ws = (unsigned char*)d_ws;
#if MK_SINGLE
    a.ph_lo = 0; a.ph_hi = NPHASE;
    if (hipMemsetAsync((char*)d_ws + WS_BAR, 0, (size_t)CTL_WORDS * 4, stream) != hipSuccess) { fprintf(stderr, "kernel_launch: memset of the barrier words failed\n"); return; }
    void* args[] = {&a};
    hipError_t e = hipLaunchCooperativeKernel((const void*)fwd_kernel, dim3(grid), dim3(512), args, LDS_BYTES, stream);
    if (e != hipSuccess) fprintf(stderr, "cooperative launch failed: %s (grid %d)\n", hipGetErrorString(e), grid);
#else
    for (int ph = 0; ph < NPHASE; ++ph) {
        if (NSEG == 1 && (ph == 4 || ph == 13)) continue;
        a.ph_lo = ph; a.ph_hi = ph + 1;
        hipLaunchKernelGGL(fwd_kernel, dim3(grid), dim3(512), LDS_BYTES, stream, a);
    }
#endif
}
```
